# Optimizing an MI355X kernel written in HIP

```python
import math
import jax, jax.numpy as jnp
from jax import lax
import numpy as np

D_MODEL = 1024
BATCH = 8
SEQ = 8192
DEPTH = 1

N_META = 16
BLOCK = 128
PAD = BLOCK - N_META

HG_HEADS = 4
HG_K = 128
HG_V = 128
HG_KW = HG_HEADS * HG_K
HG_VW = HG_HEADS * HG_V
SUB = 16

ATT_HEADS = 8
ATT_KV_HEADS = 2
HEAD_DIM = 64
ATT_QW = ATT_HEADS * HEAD_DIM
ATT_KVW = ATT_KV_HEADS * HEAD_DIM
WINDOW = 128
ROPE_THETA = 10000.0

N_BRANCH = 2
D_FF = ((-(-8 * D_MODEL // 3) + 255) // 256) * 256
EPS = 1e-5
ALPHA = (2.0 * DEPTH) ** 0.25
BETA = (8.0 * DEPTH) ** -0.25
SPLIT_SIZES = (HG_KW, HG_KW, HG_VW, HG_VW, ATT_QW, ATT_KVW, ATT_KVW, N_BRANCH * D_MODEL)
IN_W = sum(SPLIT_SIZES)

kernel_name = "hgrn2_swa_sink_hybrid_deepnorm"


def layer_norm(x, g, b):
    xf = x.astype(jnp.float32)
    mu = jnp.mean(xf, axis=-1, keepdims=True)
    var = jnp.mean(jnp.square(xf - mu), axis=-1, keepdims=True)
    y = (xf - mu) * lax.rsqrt(var + EPS) * g.astype(jnp.float32) + b.astype(jnp.float32)
    return y.astype(x.dtype)


def rope(x, pos):
    half = HEAD_DIM // 2
    inv = ROPE_THETA ** (-jnp.arange(half, dtype=jnp.float32) / half)
    ang = pos.astype(jnp.float32)[:, None] * inv[None, :]
    cos = jnp.cos(ang)[None, :, None, :]
    sin = jnp.sin(ang)[None, :, None, :]
    xf = x.astype(jnp.float32)
    x1, x2 = xf[..., :half], xf[..., half:]
    return jnp.concatenate([x1 * cos - x2 * sin, x2 * cos + x1 * sin], axis=-1).astype(x.dtype)


def hgrn2_chunk(state, inp):
    q, k, v, log_f = inp
    B, H, C, K = q.shape
    V = v.shape[-1]
    n = C // SUB
    b = jnp.cumsum(log_f, axis=2)
    b_last = b[:, :, -1]
    o_inter = jnp.einsum('bhck,bhkv->bhcv', q * jnp.exp(b), state)
    qs = q.reshape(B, H, n, SUB, K)
    ks = k.reshape(B, H, n, SUB, K)
    vs = v.reshape(B, H, n, SUB, V)
    bs = b.reshape(B, H, n, SUB, K)
    tri = jnp.tril(jnp.ones((SUB, SUB), dtype=bool))[:, :, None]
    diff = bs[:, :, :, :, None, :] - bs[:, :, :, None, :, :]
    decay = jnp.exp(jnp.where(tri, diff, -jnp.inf))
    a_diag = jnp.einsum('bhntk,bhnsk,bhntsk->bhnts', qs, ks, decay)
    o_diag = jnp.einsum('bhnts,bhnsv->bhntv', a_diag, vs)
    b_ref = jnp.concatenate([jnp.zeros_like(bs[:, :, :1, 0]), bs[:, :, :-1, -1]], axis=2)
    q_off = qs * jnp.exp(bs - b_ref[:, :, :, None])
    earlier = (jnp.arange(C) // SUB)[None, :] < jnp.arange(n)[:, None]
    k_off = k[:, :, None] * jnp.exp(jnp.where(earlier[:, :, None],
                                              b_ref[:, :, :, None] - b[:, :, None], -jnp.inf))
    a_off = jnp.einsum('bhntk,bhnsk->bhnts', q_off, k_off)
    o_off = jnp.einsum('bhnts,bhsv->bhntv', a_off, v)
    o = o_inter + (o_diag + o_off).reshape(B, H, C, V)
    new_state = state * jnp.exp(b_last)[..., None] + jnp.einsum(
        'bhck,bhcv->bhkv', k * jnp.exp(b_last[:, :, None] - b), v)
    return new_state, o


def hgrn2_mixer(q_raw, f_raw, i_raw, g_raw, lower_bound, norm_g, valid):
    B, P, _ = q_raw.shape
    N = P // BLOCK
    f32 = jnp.float32
    q = jax.nn.silu(q_raw.astype(f32))
    fg = lower_bound + (1.0 - lower_bound) * jax.nn.sigmoid(f_raw.astype(f32))
    m = valid[None, :, None]
    log_f = jnp.where(m, jnp.log(fg), 0.0)
    k = jnp.where(m, 1.0 - fg, 0.0)
    v = i_raw.astype(f32)

    def to_chunks(t, dh):
        return t.reshape(B, N, BLOCK, HG_HEADS, dh).transpose(1, 0, 3, 2, 4)

    xs = (to_chunks(q, HG_K), to_chunks(k, HG_K), to_chunks(v, HG_V), to_chunks(log_f, HG_K))
    s0 = jnp.zeros((B, HG_HEADS, HG_K, HG_V), f32)
    _, o = lax.scan(hgrn2_chunk, s0, xs)
    o = o.transpose(1, 0, 3, 2, 4).reshape(B, P, HG_HEADS, HG_V)
    o = o * lax.rsqrt(jnp.mean(o * o, axis=-1, keepdims=True) + EPS) * norm_g.astype(f32)
    gate = jax.nn.silu(g_raw.astype(f32)).reshape(B, P, HG_HEADS, HG_V)
    return (o * gate).reshape(B, P, HG_VW).astype(q_raw.dtype)


def swa_sink_attention(q_raw, k_raw, v_raw, sinks, pos):
    B, P, _ = q_raw.shape
    NB = P // BLOCK
    G = ATT_HEADS // ATT_KV_HEADS
    f32 = jnp.float32
    q = rope(q_raw.reshape(B, P, ATT_HEADS, HEAD_DIM), pos).astype(f32)
    k = rope(k_raw.reshape(B, P, ATT_KV_HEADS, HEAD_DIM), pos).astype(f32)
    v = v_raw.reshape(B, P, ATT_KV_HEADS, HEAD_DIM).astype(f32)
    scale = HEAD_DIM ** -0.5
    qb = q.reshape(B, NB, BLOCK, ATT_KV_HEADS, G, HEAD_DIM)
    kb = k.reshape(B, NB, BLOCK, ATT_KV_HEADS, HEAD_DIM)
    vb = v.reshape(B, NB, BLOCK, ATT_KV_HEADS, HEAD_DIM)
    shift = lambda t: jnp.pad(t, ((0, 0), (1, 0), (0, 0), (0, 0), (0, 0)))[:, :-1]
    k_band = jnp.concatenate([shift(kb), kb], axis=2)
    v_band = jnp.concatenate([shift(vb), vb], axis=2)
    k_meta = k[:, PAD:BLOCK]
    v_meta = v[:, PAD:BLOCK]
    pos_b = pos.reshape(NB, BLOCK)
    pos_prev = jnp.concatenate([jnp.full((1, BLOCK), -1, pos.dtype), pos_b[:-1]], axis=0)
    key_pos = jnp.concatenate([pos_prev, pos_b], axis=1)[:, None, :]
    meta_pos = pos[PAD:BLOCK][None, None, :]
    qp = pos_b[:, :, None]
    band_ok = (key_pos >= N_META) & (key_pos <= qp) & (qp - key_pos < WINDOW)
    meta_ok = meta_pos <= qp
    neg = jnp.finfo(f32).min
    s_band = jnp.einsum('bnqhgd,bnkhd->bnhgqk', qb, k_band) * scale
    s_meta = jnp.einsum('bnqhgd,bmhd->bnhgqm', qb, k_meta) * scale
    s_band = jnp.where(band_ok[None, :, None, None], s_band, neg)
    s_meta = jnp.where(meta_ok[None, :, None, None], s_meta, neg)
    sink = jnp.broadcast_to(sinks.astype(f32).reshape(ATT_KV_HEADS, G)[None, None, :, :, None, None],
                            s_meta.shape[:-1] + (1,))
    p = jax.nn.softmax(jnp.concatenate([s_meta, s_band, sink], axis=-1), axis=-1)
    p_meta = p[..., :N_META]
    p_band = p[..., N_META:N_META + 2 * BLOCK]
    o = (jnp.einsum('bnhgqm,bmhd->bnqhgd', p_meta, v_meta)
         + jnp.einsum('bnhgqk,bnkhd->bnqhgd', p_band, v_band))
    return o.reshape(B, P, ATT_QW).astype(q_raw.dtype)


def setup_inputs(seed: int = 0) -> dict:
    key = jax.random.key(seed)
    ks = jax.random.split(key, 18)
    f32 = jnp.float32
    nrm = lambda k, shape, s: jax.random.normal(k, shape, f32) * s
    return {
        "x": nrm(ks[0], (BATCH, SEQ, D_MODEL), 1.0),
        "meta_tokens": nrm(ks[1], (N_META, D_MODEL), 1.0),
        "ln_emb_g": 1.0 + nrm(ks[2], (D_MODEL,), 0.02),
        "ln_emb_b": nrm(ks[3], (D_MODEL,), 0.02),
        "w_in": nrm(ks[4], (DEPTH, D_MODEL, IN_W), D_MODEL ** -0.5),
        "hg_lower_bounds": nrm(ks[5], (DEPTH + 1, HG_KW), 0.1),
        "hg_norm_g": 1.0 + nrm(ks[6], (DEPTH, HG_V), 0.02),
        "attn_sinks": nrm(ks[7], (DEPTH, ATT_HEADS), 0.5),
        "w_branch_hg": nrm(ks[8], (DEPTH, HG_VW, D_MODEL), HG_VW ** -0.5),
        "w_branch_attn": nrm(ks[9], (DEPTH, ATT_QW, D_MODEL), ATT_QW ** -0.5),
        "w_out": nrm(ks[10], (DEPTH, D_MODEL, D_MODEL), BETA * D_MODEL ** -0.5),
        "ln1_g": 1.0 + nrm(ks[11], (DEPTH, D_MODEL), 0.02),
        "ln1_b": nrm(ks[12], (DEPTH, D_MODEL), 0.02),
        "w_ffn_in": nrm(ks[13], (DEPTH, D_MODEL, 2 * D_FF), D_MODEL ** -0.5),
        "w_ffn_out": nrm(ks[14], (DEPTH, D_FF, D_MODEL), BETA * D_FF ** -0.5),
        "ln2_g": 1.0 + nrm(ks[15], (DEPTH, D_MODEL), 0.02),
        "ln2_b": nrm(ks[16], (DEPTH, D_MODEL), 0.02),
    }


def reference(x, meta_tokens, ln_emb_g, ln_emb_b, w_in, hg_lower_bounds, hg_norm_g, attn_sinks,
              w_branch_hg, w_branch_attn, w_out, ln1_g, ln1_b, w_ffn_in, w_ffn_out, ln2_g, ln2_b):
    B, S, D = x.shape
    P = S + BLOCK
    meta = jnp.broadcast_to(meta_tokens.astype(x.dtype)[None], (B, N_META, D))
    h = layer_norm(jnp.concatenate([meta, x], axis=1), ln_emb_g, ln_emb_b)
    h = jnp.pad(h, ((0, 0), (PAD, 0), (0, 0)))
    pos = jnp.arange(P, dtype=jnp.int32) - PAD
    valid = pos >= 0
    lbs = jnp.cumsum(jax.nn.softmax(hg_lower_bounds.astype(jnp.float32), axis=0), axis=0)
    split_idx = [sum(SPLIT_SIZES[:i + 1]) for i in range(len(SPLIT_SIZES) - 1)]
    for l in range(DEPTH):
        proj = h @ w_in[l]
        hq, hf, hi, hg, aq, ak, av, gates = jnp.split(proj, split_idx, axis=-1)
        y_hg = hgrn2_mixer(hq, hf, hi, hg, lbs[l], hg_norm_g[l], valid) @ w_branch_hg[l]
        y_att = swa_sink_attention(aq, ak, av, attn_sinks[l], pos) @ w_branch_attn[l]
        g_hg, g_att = jnp.split(jax.nn.sigmoid(gates), N_BRANCH, axis=-1)
        mix = (g_hg * y_hg + g_att * y_att) @ w_out[l]
        h = layer_norm(ALPHA * h + mix, ln1_g[l], ln1_b[l])
        a, u = jnp.split(h @ w_ffn_in[l], 2, axis=-1)
        h = layer_norm(ALPHA * h + (jax.nn.silu(a) * u) @ w_ffn_out[l], ln2_g[l], ln2_b[l])
    return h[:, BLOCK:]
```

```cpp
#include <hip/hip_runtime.h>
#include <hip/hip_cooperative_groups.h>
#include <cstdio>
namespace cg = cooperative_groups;

#ifndef PROBE_A
#define PROBE_A 1
#endif
#ifndef PROBE_B
#define PROBE_B 1
#endif
#ifndef PROBE_C
#define PROBE_C 1
#endif
#ifndef PROBE_D
#define PROBE_D 1
#endif
#ifndef PROBE_P1
#define PROBE_P1 1
#endif
#ifndef REP_P0
#define REP_P0 1
#endif
#ifndef REP_G1
#define REP_G1 1
#endif
#ifndef REP_MIX
#define REP_MIX 1
#endif
#ifndef REP_SC
#define REP_SC 1
#endif
#ifndef MK_LAUNCHES
#define MK_LAUNCHES 1
#endif

#define DEVI __device__ __forceinline__
typedef unsigned short u16;
using bf16x8 = __attribute__((ext_vector_type(8))) short;
using bf16x4 = __attribute__((ext_vector_type(4))) short;
using f32x4 = __attribute__((ext_vector_type(4))) float;

constexpr int NT = 512;
constexpr int ROWS = 65536;
constexpr int NTILE = 256;
constexpr int INW = 4864;
constexpr int DFF = 2816;
constexpr float EPSF = 1e-5f;
constexpr float ALPHA = 1.189207115002721f;

constexpr size_t OFF_WINT  = 0;
constexpr size_t OFF_WBHG  = OFF_WINT  + (size_t)INW * 1024 * 2;
constexpr size_t OFF_WBATT = OFF_WBHG  + (size_t)1024 * 512 * 2;
constexpr size_t OFF_WOUT  = OFF_WBATT + (size_t)1024 * 512 * 2;
constexpr size_t OFF_WFI   = OFF_WOUT  + (size_t)1024 * 1024 * 2;
constexpr size_t OFF_WFO   = OFF_WFI   + (size_t)2 * DFF * 1024 * 2;
constexpr size_t OFF_STATS = OFF_WFO   + (size_t)1024 * DFF * 2;
constexpr size_t OFF_ROPE  = OFF_STATS + (size_t)ROWS * 2 * 4;
constexpr size_t OFF_MLOGF = OFF_ROPE  + (size_t)8208 * 32 * 2 * 4;
constexpr size_t OFF_MV    = OFF_MLOGF + (size_t)16 * 512 * 4;
constexpr size_t OFF_STATS2= OFF_MV    + (size_t)16 * 512 * 4;
constexpr size_t OFF_DVEC  = OFF_STATS2+ (size_t)ROWS * 2 * 4;
constexpr size_t OFF_R1    = OFF_DVEC  + (size_t)2048 * 128 * 4;
constexpr size_t OFF_HQ    = OFF_R1    + (size_t)ROWS * 1024 * 2;
constexpr size_t OFF_HV    = OFF_HQ    + (size_t)ROWS * 512 * 2;
constexpr size_t OFF_HG    = OFF_HV    + (size_t)ROWS * 512 * 2;
constexpr size_t OFF_AQ    = OFF_HG    + (size_t)ROWS * 512 * 2;
constexpr size_t OFF_AK    = OFF_AQ    + (size_t)ROWS * 512 * 2;
constexpr size_t OFF_AV    = OFF_AK    + (size_t)(ROWS + 16) * 128 * 2;
constexpr size_t OFF_GL    = OFF_AV    + (size_t)(ROWS + 16) * 128 * 2;
constexpr size_t GL_BLOCK  = (size_t)256 * 2048 * 2 + (size_t)256 * 512 * 4;
constexpr size_t GL_LOGF   = (size_t)256 * 2048 * 2;
constexpr size_t OFF_HO    = OFF_GL    + (size_t)NTILE * GL_BLOCK;
constexpr size_t OFF_AO    = OFF_HO    + (size_t)ROWS * 512 * 2;
constexpr size_t WS_END    = OFF_AO    + (size_t)ROWS * 512 * 2;
constexpr size_t DOUT_H0   = (size_t)2048 * 128 * 128 * 4;

constexpr int LDS_BYTES = 144 * 1024;

struct Params {
  const float *x, *meta, *lng, *lnb, *w_in, *hglb, *hgng, *sinks, *w_bhg, *w_batt, *w_out, *ln1g, *ln1b, *w_fi, *w_fo, *ln2g, *ln2b;
  float* out;
  char* ws;
  int ph_lo, ph_hi;
};

DEVI unsigned pack2(float a, float b) { unsigned r; asm("v_cvt_pk_bf16_f32 %0, %1, %2" : "=v"(r) : "v"(a), "v"(b)); return r; }
DEVI u16 f2bf(float f) { return (u16)(pack2(f, 0.f) & 0xffffu); }
DEVI float bf2f(u16 h) { return __uint_as_float(((unsigned)h) << 16); }
DEVI float bflo(unsigned w) { return __uint_as_float(w << 16); }
DEVI float bfhi(unsigned w) { return __uint_as_float(w & 0xffff0000u); }
DEVI float sigm(float x) { return __builtin_amdgcn_rcpf(1.0f + __expf(-x)); }
DEVI float silu(float x) { return x * sigm(x); }
DEVI float wave_sum(float v) {
#pragma unroll
  for (int o = 32; o; o >>= 1) v += __shfl_xor(v, o);
  return v;
}
DEVI float lb_of(const Params& p, int j) { return 1.0f / (1.0f + __expf(p.hglb[512 + j] - p.hglb[j])); }

DEVI size_t opaque_zero() { size_t z = 0; asm volatile("" : "+s"(z)); return z; }
DEVI char* opaque_ptr(char* q) { return q + opaque_zero(); }
DEVI int opaque_tid() { int t = threadIdx.x; asm volatile("" : "+v"(t)); return t; }

DEVI void rope_cs(int pos, int fi, float& c, float& s) {
  double invd = 1.0;
  if (fi & 1) invd *= 0.7498942093324559;
  if (fi & 2) invd *= 0.5623413251903491;
  if (fi & 4) invd *= 0.31622776601683794;
  if (fi & 8) invd *= 0.1;
  if (fi & 16) invd *= 0.01;
  float inv = (float)invd;
  float ang = (float)pos * inv;
  double a = (double)ang;
  double n = rint(a * 0.15915494309189535);
  double r = fma(-n, 6.283185307179586, a);
  r = fma(-n, 2.4492935982947064e-16, r);
  double r2 = r * r, ts = r, tc = 1.0, ss = r, cc = 1.0;
#pragma unroll
  for (int i = 1; i <= 12; ++i) {
    tc *= -r2 / (double)((2 * i - 1) * (2 * i)); cc += tc;
    ts *= -r2 / (double)((2 * i) * (2 * i + 1)); ss += ts;
  }
  c = (float)cc; s = (float)ss;
}

DEVI void stage_rc(int b, int& R, int& C) {
  int st = b / 1024, sb = b % 1024, swz = sb ^ (((sb >> 9) & 1) << 5);
  R = (st >> 1) * 16 + swz / 64; C = (st & 1) * 32 + (swz % 64) / 2;
}
DEVI int lds_byte(int r, int c) {
  int st = (r >> 4) * 2 + (c >> 5), rr = r & 15, cc = c & 31, ob = rr * 64 + cc * 2;
  return st * 1024 + (ob ^ (((ob >> 9) & 1) << 5));
}

DEVI size_t blk(int K, int tile, int lr, int col) { return (size_t)tile * 256 * K + ((size_t)(col >> 6) * 256 + lr) * 64 + (col & 63); }
DEVI int perm32(int rho) { const int n = rho >> 4, i = rho & 15; return 8 * (i >> 2) + 4 * n + (i & 3); }
DEVI const char* opaque_cptr(const char* q) { return q + opaque_zero(); }

template <int K, class UF, class EF>
DEVI void gemm_stream(const int nunits, UF&& unitf, EF&& epif, char* shm) {
  constexpr int BK = 64, HALF = 128, HTB = HALF * BK * 2;
  if (nunits <= 0) return;
  const int tid = opaque_tid();
  const int wid = tid >> 6, lane = tid & 63, wr = wid >> 2, wc = wid & 3, fr = lane & 15, fq = lane >> 4;
  unsigned voffA0, voffA1, voffB0, voffB1;
  {
    int r0, c0, r1, c1;
    stage_rc(tid * 16, r0, c0); stage_rc(tid * 16 + 8192, r1, c1);
    voffA0 = (unsigned)(r0 * 64 + c0) * 2u; voffA1 = (unsigned)(r1 * 64 + c1) * 2u;
    voffB0 = (unsigned)(((r0 & ~31) + perm32(r0 & 31)) * 64 + c0) * 2u; voffB1 = (unsigned)(((r1 & ~31) + perm32(r1 & 31)) * 64 + c1) * 2u;
  }
  constexpr size_t kstep = (size_t)256 * BK * 2;
  constexpr size_t hstep = (size_t)HALF * BK * 2;
#define SA(b, h) (shm + ((b) * 2 + (h)) * HTB)
#define SB(b, h) (shm + (4 + (b) * 2 + (h)) * HTB)
#define STAGE(P, GBASE, V0, V1) do { const char* _g = opaque_cptr(GBASE); \
    __builtin_amdgcn_global_load_lds((const unsigned*)(_g + (V0)), (unsigned*)((P) + tid * 16), 16, 0, 0); \
    __builtin_amdgcn_global_load_lds((const unsigned*)(_g + (V1)), (unsigned*)((P) + tid * 16 + 8192), 16, 0, 0); } while (0)
#define STAGE_A(P, G) STAGE(P, G, voffA0, voffA1)
#define STAGE_B(P, G) STAGE(P, G, voffB0, voffB1)
#define LDA(dst, b, h) _Pragma("unroll") for (int m = 0; m < 4; ++m) _Pragma("unroll") for (int k = 0; k < 2; ++k) \
    dst[m][k] = *reinterpret_cast<const bf16x8*>(SA(b, h) + lds_byte(wr * 64 + m * 16 + fr, k * 32 + fq * 8))
#define LDB(dst, b, h) _Pragma("unroll") for (int n = 0; n < 2; ++n) _Pragma("unroll") for (int k = 0; k < 2; ++k) \
    dst[n][k] = *reinterpret_cast<const bf16x8*>(SB(b, h) + lds_byte(wc * 32 + n * 16 + fr, k * 32 + fq * 8))
#define MMA(ai, bj, At_, Bt_) do { __builtin_amdgcn_s_setprio(1); \
    _Pragma("unroll") for (int m = 0; m < 4; ++m) _Pragma("unroll") for (int n = 0; n < 2; ++n) _Pragma("unroll") for (int k = 0; k < 2; ++k) \
      acc[ai][bj][m][n] = __builtin_amdgcn_mfma_f32_16x16x32_bf16(Bt_[n][k], At_[m][k], acc[ai][bj][m][n], 0, 0, 0); \
    __builtin_amdgcn_s_setprio(0); } while (0)
#define WAIT_V(n) asm volatile("s_waitcnt vmcnt(" #n ")" ::: "memory")
#define WAIT_L(n) asm volatile("s_waitcnt lgkmcnt(" #n ")" ::: "memory")
#define BAR __builtin_amdgcn_s_barrier()
#define SCHED __builtin_amdgcn_sched_barrier(0)
  f32x4 acc[2][2][4][2];
#pragma unroll
  for (int a = 0; a < 2; ++a)
#pragma unroll
    for (int b = 0; b < 2; ++b)
#pragma unroll
      for (int m = 0; m < 4; ++m)
#pragma unroll
        for (int n = 0; n < 2; ++n) acc[a][b][m][n] = f32x4{0.f, 0.f, 0.f, 0.f};
  bf16x8 At[4][2], B0[2][2], B1[2][2];
  constexpr int nt = K / BK;
  const char* cA; const char* cB;
  unitf(0, cA, cB);
  STAGE_B(SB(0, 0), cB); STAGE_A(SA(0, 0), cA); STAGE_B(SB(0, 1), cB + hstep); STAGE_A(SA(0, 1), cA + hstep);
  if (wr == 1) BAR;
  WAIT_V(4); BAR;
  STAGE_B(SB(1, 0), cB + kstep); STAGE_A(SA(1, 0), cA + kstep); STAGE_B(SB(1, 1), cB + hstep + kstep);
  WAIT_V(6); BAR;
#pragma unroll 1
  for (int ui = 0; ui < nunits; ++ui) {
    const bool has_next = (ui + 1 < nunits);
    const char* nA = cA; const char* nB = cB;
    if (has_next) unitf(ui + 1, nA, nB);
#pragma unroll 1
    for (int t = 0; t < nt; t += 2) {
      const bool last = (t == nt - 2);
      const char* a1 = cA + (size_t)(t + 1) * kstep;
      const char* a2 = last ? nA : cA + (size_t)(t + 2) * kstep;
      const char* b2 = last ? nB : cB + (size_t)(t + 2) * kstep;
      const char* a3 = a2 + kstep; const char* b3 = b2 + kstep;
      LDB(B0, 0, 0); SCHED; LDA(At, 0, 0); STAGE_A(SA(1, 1), a1 + hstep);
      WAIT_L(8); BAR; WAIT_L(0); MMA(0, 0, At, B0); BAR; SCHED;
      LDB(B1, 0, 1); STAGE_B(SB(0, 0), b2);
      BAR; WAIT_L(0); MMA(0, 1, At, B1); BAR;
      LDA(At, 0, 1); STAGE_A(SA(0, 0), a2);
      BAR; WAIT_L(0); MMA(1, 0, At, B0); BAR; SCHED;
      STAGE_B(SB(0, 1), b2 + hstep);
      WAIT_V(6); BAR; MMA(1, 1, At, B1); BAR;
      LDB(B0, 1, 0); SCHED; LDA(At, 1, 0); STAGE_A(SA(0, 1), a2 + hstep);
      WAIT_L(8); BAR; WAIT_L(0); MMA(0, 0, At, B0); BAR; SCHED;
      LDB(B1, 1, 1); STAGE_B(SB(1, 0), b3);
      BAR; WAIT_L(0); MMA(0, 1, At, B1); BAR;
      LDA(At, 1, 1); STAGE_A(SA(1, 0), a3);
      BAR; WAIT_L(0); MMA(1, 0, At, B0); BAR; SCHED;
      STAGE_B(SB(1, 1), b3 + hstep);
      WAIT_V(6); BAR; MMA(1, 1, At, B1); BAR;
    }
    epif(ui, acc, wr, wc, fr, fq);
#pragma unroll
    for (int a = 0; a < 2; ++a)
#pragma unroll
      for (int b = 0; b < 2; ++b)
#pragma unroll
        for (int m = 0; m < 4; ++m)
#pragma unroll
          for (int n = 0; n < 2; ++n) acc[a][b][m][n] = f32x4{0.f, 0.f, 0.f, 0.f};
    cA = nA; cB = nB;
  }
  WAIT_V(0);
  if (wr == 0) BAR;
  BAR;
#undef SA
#undef SB
#undef STAGE
#undef STAGE_A
#undef STAGE_B
#undef LDA
#undef LDB
#undef MMA
}

enum { EPI_ACT = 0, EPI_F, EPI_AQ, EPI_AKV, EPI_ATT, EPI_HG, EPI_OUT, EPI_FFI, EPI_FFO };

DEVI void st_bf8(u16* dst, const float (&y)[8]) {
  uint4 o; o.x = pack2(y[0], y[1]); o.y = pack2(y[2], y[3]); o.z = pack2(y[4], y[5]); o.w = pack2(y[6], y[7]);
  *(uint4*)dst = o;
}
DEVI void ld_bf8(const u16* src, float (&y)[8]) {
  uint4 o = *(const uint4*)src;
  y[0] = bflo(o.x); y[1] = bfhi(o.x); y[2] = bflo(o.y); y[3] = bfhi(o.y); y[4] = bflo(o.z); y[5] = bfhi(o.z); y[6] = bflo(o.w); y[7] = bfhi(o.w);
}
DEVI void ld_f8(const float* src, float (&y)[8]) {
  float4 a = *(const float4*)src, b = *(const float4*)(src + 4);
  y[0] = a.x; y[1] = a.y; y[2] = a.z; y[3] = a.w; y[4] = b.x; y[5] = b.y; y[6] = b.z; y[7] = b.w;
}
DEVI void st_f8(float* dst, const float (&y)[8]) {
  *(float4*)dst = make_float4(y[0], y[1], y[2], y[3]); *(float4*)(dst + 4) = make_float4(y[4], y[5], y[6], y[7]);
}

DEVI void rope8(const float (&x1)[8], const float (&x2)[8], const float4* tab, float sc, float (&y1)[8], float (&y2)[8]) {
#pragma unroll
  for (int e2 = 0; e2 < 4; ++e2) {
    const float4 cs = tab[e2];
    y1[2 * e2] = (x1[2 * e2] * cs.x - x2[2 * e2] * cs.y) * sc;
    y2[2 * e2] = (x2[2 * e2] * cs.x + x1[2 * e2] * cs.y) * sc;
    y1[2 * e2 + 1] = (x1[2 * e2 + 1] * cs.z - x2[2 * e2 + 1] * cs.w) * sc;
    y2[2 * e2 + 1] = (x2[2 * e2 + 1] * cs.z + x1[2 * e2 + 1] * cs.w) * sc;
  }
}

template <int EPI>
DEVI void epi_regs(const Params& p, int mt, int nt, const f32x4 (&acc)[2][2][4][2], int, int, int, int,
                   int mode = 0, u16* dstb = nullptr, int dstride = 0, int dcol = 0) {
  const int tid_ = opaque_tid();
  const int wr = tid_ >> 8, wc = (tid_ >> 6) & 3, fr = tid_ & 15, fq = (tid_ >> 4) & 3;
  char* ws = opaque_ptr(p.ws);
  char* gl = ws + OFF_GL + (size_t)mt * GL_BLOCK;
  const int c0 = wc * 32 + fq * 8;
  float lbv[2][8];
  if (EPI == EPI_F) {
#pragma unroll
    for (int bj = 0; bj < 2; ++bj)
#pragma unroll
      for (int e = 0; e < 8; ++e) lbv[bj][e] = lb_of(p, (nt & 1) * 256 + bj * 128 + c0 + e);
  }
#pragma unroll
  for (int ai = 0; ai < 2; ++ai)
#pragma unroll
    for (int m = 0; m < 4; ++m) {
      const int lr = ai * 128 + wr * 64 + m * 16 + fr;
      const size_t R = (size_t)mt * 256 + lr;
      float va[8], vb[8];
#pragma unroll
      for (int e = 0; e < 4; ++e) { va[e] = acc[ai][0][m][0][e]; va[4 + e] = acc[ai][0][m][1][e]; vb[e] = acc[ai][1][m][0][e]; vb[4 + e] = acc[ai][1][m][1][e]; }
      if (EPI == EPI_AQ) {
        const int hl = c0 >> 5, d0 = c0 & 31;
        const int pos = 16 + (int)(R & 8191);
        const float4* tab = (const float4*)((const float*)(ws + OFF_ROPE) + ((size_t)pos * 32 + d0) * 2);
        float y1[8], y2[8];
        rope8(va, vb, tab, 0.125f, y1, y2);
        u16* dst = (u16*)(ws + OFF_AQ) + R * 512 + (nt & 1) * 256 + hl * 64 + d0;
        st_bf8(dst, y1); st_bf8(dst + 32, y2);
      } else if (EPI == EPI_AKV) {
        if (c0 < 64) {
          const int hl = c0 >> 5, d0 = c0 & 31;
          const int pos = 16 + (int)(R & 8191);
          const float4* tab = (const float4*)((const float*)(ws + OFF_ROPE) + ((size_t)pos * 32 + d0) * 2);
          float y1[8], y2[8];
          rope8(va, vb, tab, 1.0f, y1, y2);
          u16* dst = (u16*)(ws + OFF_AK) + (R + 16) * 128 + hl * 64 + d0;
          st_bf8(dst, y1); st_bf8(dst + 32, y2);
        } else {
          u16* dst = (u16*)(ws + OFF_AV) + (R + 16) * 128 + (c0 - 64);
          st_bf8(dst, va); st_bf8(dst + 64, vb);
        }
      } else if (EPI == EPI_FFI) {
        float y[8];
#pragma unroll
        for (int e = 0; e < 8; ++e) y[e] = silu(va[e]) * vb[e];
        st_bf8((u16*)gl + blk(DFF, 0, lr, nt * 128 + c0), y);
      } else {
#pragma unroll
        for (int bj = 0; bj < 2; ++bj) {
          const int c = bj * 128 + c0;
          float v[8], y[8];
#pragma unroll
          for (int e = 0; e < 8; ++e) v[e] = bj ? vb[e] : va[e];
          if (EPI == EPI_ACT) {
            if (mode == 0) {
#pragma unroll
              for (int e = 0; e < 8; ++e) y[e] = v[e];
            } else {
#pragma unroll
              for (int e = 0; e < 8; ++e) { const float s = sigm(v[e]); y[e] = mode == 1 ? v[e] * s : s; }
            }
            st_bf8(dstb + (size_t)lr * dstride + dcol + c, y);
          } else if (EPI == EPI_F) {
            const int j0 = (nt & 1) * 256 + c;
#pragma unroll
            for (int e = 0; e < 8; ++e) { const float lb = lbv[bj][e]; y[e] = __logf(lb + (1.0f - lb) * sigm(v[e])); }
            st_f8((float*)(gl + GL_LOGF) + lr * 512 + j0, y);
          } else if (EPI == EPI_ATT) {
            const int col = nt * 256 + c;
            float g[8];
            ld_bf8((const u16*)gl + lr * 2048 + 1024 + col, g);
#pragma unroll
            for (int e = 0; e < 8; ++e) y[e] = g[e] * v[e];
            st_f8(p.out + R * 1024 + col, y);
          } else if (EPI == EPI_HG) {
            const int col = nt * 256 + c;
            float g[8], t[8];
            ld_bf8((const u16*)gl + lr * 2048 + col, g);
            ld_f8(p.out + R * 1024 + col, t);
#pragma unroll
            for (int e = 0; e < 8; ++e) y[e] = t[e] + g[e] * v[e];
            st_bf8((u16*)(ws + OFF_R1) + blk(1024, mt, lr, col), y);
          } else if (EPI == EPI_OUT) {
            const int col = nt * 256 + c;
            float xv[8], gm[8], bt[8];
            ld_f8(p.x + R * 1024 + col, xv);
            ld_f8(p.lng + col, gm);
            ld_f8(p.lnb + col, bt);
            const float2 st = *(const float2*)((const float*)(ws + OFF_STATS) + R * 2);
#pragma unroll
            for (int e = 0; e < 8; ++e) y[e] = ALPHA * ((xv[e] - st.x) * st.y * gm[e] + bt[e]) + v[e];
            st_f8(p.out + R * 1024 + col, y);
          } else if (EPI == EPI_FFO) {
            const int col = nt * 256 + c;
            float t[8], gm[8], bt[8];
            ld_f8(p.out + R * 1024 + col, t);
            ld_f8(p.ln1g + col, gm);
            ld_f8(p.ln1b + col, bt);
            const float2 st = *(const float2*)((const float*)(ws + OFF_STATS2) + R * 2);
#pragma unroll
            for (int e = 0; e < 8; ++e) y[e] = ALPHA * ((t[e] - st.x) * st.y * gm[e] + bt[e]) + v[e];
            st_f8(p.out + R * 1024 + col, y);
          }
        }
      }
    }
}


DEVI void ln_rows(const Params& p, int mt, const float* g, const float* b, u16* bfout) {
  const int tid = opaque_tid(), wid = tid >> 6, lane = tid & 63;
#pragma unroll 1
  for (int rr = wid * 4; rr < 256; rr += 32) {
    float4 v[4][4];
#pragma unroll
    for (int q = 0; q < 4; ++q) {
      const float4* row = (const float4*)(p.out + ((size_t)mt * 256 + rr + q) * 1024);
#pragma unroll
      for (int i = 0; i < 4; ++i) v[q][i] = row[i * 64 + lane];
    }
#pragma unroll
    for (int q = 0; q < 4; ++q) {
      const size_t R = (size_t)mt * 256 + rr + q;
      float4* row = (float4*)(p.out + R * 1024);
      float s = 0.f;
#pragma unroll
      for (int i = 0; i < 4; ++i) s += v[q][i].x + v[q][i].y + v[q][i].z + v[q][i].w;
      const float mu = wave_sum(s) * (1.0f / 1024.0f);
      float qq = 0.f;
#pragma unroll
      for (int i = 0; i < 4; ++i) { float a = v[q][i].x - mu, bb = v[q][i].y - mu, c = v[q][i].z - mu, d = v[q][i].w - mu; qq += a * a + bb * bb + c * c + d * d; }
      const float rstd = rsqrtf(wave_sum(qq) * (1.0f / 1024.0f) + EPSF);
      if (bfout && lane == 0) { float* st2 = (float*)(opaque_ptr(p.ws) + OFF_STATS2); st2[R * 2] = mu; st2[R * 2 + 1] = rstd; }
#pragma unroll
      for (int i = 0; i < 4; ++i) {
        float4 g4 = ((const float4*)g)[i * 64 + lane], b4 = ((const float4*)b)[i * 64 + lane];
        float4 y;
        y.x = (v[q][i].x - mu) * rstd * g4.x + b4.x; y.y = (v[q][i].y - mu) * rstd * g4.y + b4.y;
        y.z = (v[q][i].z - mu) * rstd * g4.z + b4.z; y.w = (v[q][i].w - mu) * rstd * g4.w + b4.w;
        if (!bfout) row[i * 64 + lane] = y;
        if (bfout) { uint2 o; o.x = pack2(y.x, y.y); o.y = pack2(y.z, y.w); *(uint2*)(bfout + blk(1024, mt, rr + q, i * 256 + lane * 4)) = o; }
      }
    }
  }
}

DEVI int map_win(int n) {
  if (n < 2048 || n >= 2816) return n;
  if (n < 2560) { const int q = n - 2048, head = q >> 6, d = q & 63; return 2048 + (head >> 2) * 256 + (d >> 5) * 128 + (head & 3) * 32 + (d & 31); }
  if (n < 2688) { const int q = n - 2560, head = q >> 6, d = q & 63; return 2560 + (d >> 5) * 128 + head * 32 + (d & 31); }
  const int q = n - 2688; return 2560 + (q >> 6) * 128 + 64 + (q & 63);
}
DEVI int map_wfi(int n) { return n < DFF ? 256 * (n / 128) + (n % 128) : 256 * ((n - DFF) / 128) + 128 + ((n - DFF) % 128); }

template <int MAP>
DEVI void transpose_tile(const float* __restrict__ src, int K, int N, u16* __restrict__ dst, int k0, int n0, float* tl) {
  const int tid = opaque_tid();
#pragma unroll
  for (int it = 0; it < 8; ++it) { int i = tid + it * NT; int r = i >> 6, c = i & 63; tl[r * 65 + c] = src[(size_t)(k0 + r) * N + n0 + c]; }
  __syncthreads();
#pragma unroll
  for (int it = 0; it < 8; ++it) {
    int i = tid + it * NT; int nn = i >> 6, kk = i & 63;
    const int n = n0 + nn;
    const int dr = MAP == 1 ? map_win(n) : (MAP == 2 ? map_wfi(n) : n);
    dst[blk(K, dr >> 8, dr & 255, k0 + kk)] = f2bf(tl[kk * 65 + nn]);
  }
  __syncthreads();
}

DEVI void phase0(const Params& p, char* smem) {
  const int tid = opaque_tid(), wid = tid >> 6, lane = tid & 63;
  char* ws = opaque_ptr(p.ws);
  {
    float* tl = (float*)smem;
    const bool split_meta = gridDim.x >= 64;
    const int tw = split_meta ? (int)gridDim.x - 20 : (int)gridDim.x;
    for (int t = blockIdx.x; t < 3840 && (int)blockIdx.x < tw; t += tw) {
      if (t < 1216) { int kt = t / 76, ntl = t % 76; transpose_tile<1>(p.w_in, 1024, INW, (u16*)(ws + OFF_WINT), kt * 64, ntl * 64, tl); }
      else if (t < 1344) { int q = t - 1216; int kt = q / 16, ntl = q % 16; transpose_tile<0>(p.w_bhg, 512, 1024, (u16*)(ws + OFF_WBHG), kt * 64, ntl * 64, tl); }
      else if (t < 1472) { int q = t - 1344; int kt = q / 16, ntl = q % 16; transpose_tile<0>(p.w_batt, 512, 1024, (u16*)(ws + OFF_WBATT), kt * 64, ntl * 64, tl); }
      else if (t < 1728) { int q = t - 1472; int kt = q / 16, ntl = q % 16; transpose_tile<0>(p.w_out, 1024, 1024, (u16*)(ws + OFF_WOUT), kt * 64, ntl * 64, tl); }
      else if (t < 3136) { int q = t - 1728; int kt = q / 88, ntl = q % 88; transpose_tile<2>(p.w_fi, 1024, 2 * DFF, (u16*)(ws + OFF_WFI), kt * 64, ntl * 64, tl); }
      else { int q = t - 3136; int kt = q / 16, ntl = q % 16; transpose_tile<0>(p.w_fo, DFF, 1024, (u16*)(ws + OFF_WFO), kt * 64, ntl * 64, tl); }
    }
  }
  {
    u16* h0 = (u16*)((char*)p.out + DOUT_H0);
    float* stats = (float*)(ws + OFF_STATS);
    for (int R0 = (blockIdx.x * 8 + wid) * 2; R0 < ROWS; R0 += gridDim.x * 16) {
      float4 v[2][4];
#pragma unroll
      for (int q = 0; q < 2; ++q) {
        const float4* xr = (const float4*)(p.x + (size_t)(R0 + q) * 1024);
#pragma unroll
        for (int i = 0; i < 4; ++i) v[q][i] = xr[i * 64 + lane];
      }
#pragma unroll
      for (int q = 0; q < 2; ++q) {
        const int R = R0 + q;
        float s = 0.f;
#pragma unroll
        for (int i = 0; i < 4; ++i) s += v[q][i].x + v[q][i].y + v[q][i].z + v[q][i].w;
        const float mu = wave_sum(s) * (1.0f / 1024.0f);
        float qq = 0.f;
#pragma unroll
        for (int i = 0; i < 4; ++i) { float a = v[q][i].x - mu, bb = v[q][i].y - mu, c = v[q][i].z - mu, d = v[q][i].w - mu; qq += a * a + bb * bb + c * c + d * d; }
        const float rstd = rsqrtf(wave_sum(qq) * (1.0f / 1024.0f) + EPSF);
#pragma unroll
        for (int i = 0; i < 4; ++i) {
          float4 g4 = ((const float4*)p.lng)[i * 64 + lane], b4 = ((const float4*)p.lnb)[i * 64 + lane];
          uint2 o;
          o.x = pack2((v[q][i].x - mu) * rstd * g4.x + b4.x, (v[q][i].y - mu) * rstd * g4.y + b4.y);
          o.y = pack2((v[q][i].z - mu) * rstd * g4.z + b4.z, (v[q][i].w - mu) * rstd * g4.w + b4.w);
          *(uint2*)(h0 + blk(1024, R >> 8, R & 255, i * 256 + lane * 4)) = o;
        }
        if (lane == 0) { stats[(size_t)R * 2] = mu; stats[(size_t)R * 2 + 1] = rstd; }
      }
    }
  }
  {
    float2* tab = (float2*)(ws + OFF_ROPE);
    for (int i = blockIdx.x * NT + tid; i < 8208 * 32; i += gridDim.x * NT) {
      float c, s; rope_cs(i >> 5, i & 31, c, s);
      tab[i] = make_float2(c, s);
    }
  }
  {
    float* hm = (float*)smem;
    float* red = (float*)(smem + 65536);
    float* outb = (float*)(smem + 65536 + 32768);
    const bool split_meta = gridDim.x >= 64;
    const int g0 = split_meta ? (int)blockIdx.x - ((int)gridDim.x - 20) : (int)blockIdx.x;
    for (int g = g0; g >= 0 && g < 20; g += (split_meta ? 20 : (int)gridDim.x)) {
      __syncthreads();
      for (int rr = 0; rr < 2; ++rr) {
        const int row = wid * 2 + rr;
        const float4* xr = (const float4*)(p.meta + (size_t)row * 1024);
        float4 v[4];
#pragma unroll
        for (int i = 0; i < 4; ++i) v[i] = xr[i * 64 + lane];
        float s = 0.f;
#pragma unroll
        for (int i = 0; i < 4; ++i) s += v[i].x + v[i].y + v[i].z + v[i].w;
        const float mu = wave_sum(s) * (1.0f / 1024.0f);
        float q = 0.f;
#pragma unroll
        for (int i = 0; i < 4; ++i) { float a = v[i].x - mu, bb = v[i].y - mu, c = v[i].z - mu, d = v[i].w - mu; q += a * a + bb * bb + c * c + d * d; }
        const float rstd = rsqrtf(wave_sum(q) * (1.0f / 1024.0f) + EPSF);
#pragma unroll
        for (int i = 0; i < 4; ++i) {
          float4 g4 = ((const float4*)p.lng)[i * 64 + lane], b4 = ((const float4*)p.lnb)[i * 64 + lane];
          const int k = i * 256 + lane * 4;
          hm[(k + 0) * 16 + row] = (v[i].x - mu) * rstd * g4.x + b4.x;
          hm[(k + 1) * 16 + row] = (v[i].y - mu) * rstd * g4.y + b4.y;
          hm[(k + 2) * 16 + row] = (v[i].z - mu) * rstd * g4.z + b4.z;
          hm[(k + 3) * 16 + row] = (v[i].w - mu) * rstd * g4.w + b4.w;
        }
      }
      __syncthreads();
      const int colbase = g < 8 ? 512 + g * 64 : g < 16 ? 1024 + (g - 8) * 64 : g < 18 ? 2560 + (g - 16) * 64 : 2688 + (g - 18) * 64;
      const int col = colbase + lane;
      float a0 = 0, a1 = 0, a2 = 0, a3 = 0, a4 = 0, a5 = 0, a6 = 0, a7 = 0, a8 = 0, a9 = 0, a10 = 0, a11 = 0, a12 = 0, a13 = 0, a14 = 0, a15 = 0;
#pragma unroll 4
      for (int k = wid * 128; k < wid * 128 + 128; ++k) {
        const float wv = p.w_in[(size_t)k * INW + col];
        const float4* h4 = (const float4*)(hm + k * 16);
        const float4 A = h4[0], B = h4[1], C = h4[2], D = h4[3];
        a0 += A.x * wv; a1 += A.y * wv; a2 += A.z * wv; a3 += A.w * wv;
        a4 += B.x * wv; a5 += B.y * wv; a6 += B.z * wv; a7 += B.w * wv;
        a8 += C.x * wv; a9 += C.y * wv; a10 += C.z * wv; a11 += C.w * wv;
        a12 += D.x * wv; a13 += D.y * wv; a14 += D.z * wv; a15 += D.w * wv;
      }
      float* rw = red + (wid * 16) * 64 + lane;
      rw[0 * 64] = a0; rw[1 * 64] = a1; rw[2 * 64] = a2; rw[3 * 64] = a3; rw[4 * 64] = a4; rw[5 * 64] = a5; rw[6 * 64] = a6; rw[7 * 64] = a7;
      rw[8 * 64] = a8; rw[9 * 64] = a9; rw[10 * 64] = a10; rw[11 * 64] = a11; rw[12 * 64] = a12; rw[13 * 64] = a13; rw[14 * 64] = a14; rw[15 * 64] = a15;
      __syncthreads();
      for (int i = tid; i < 1024; i += NT) {
        const int r = i >> 6, l = i & 63;
        float s = 0.f;
#pragma unroll
        for (int w = 0; w < 8; ++w) s += red[(w * 16 + r) * 64 + l];
        outb[r * 64 + l] = s;
      }
      __syncthreads();
      for (int i = tid; i < 1024; i += NT) {
        const int r = i >> 6, l = i & 63;
        const float val = outb[r * 64 + l];
        if (g < 8) {
          const int j = g * 64 + l; const float lb = lb_of(p, j);
          ((float*)(ws + OFF_MLOGF))[r * 512 + j] = __logf(lb + (1.0f - lb) * sigm(val));
        } else if (g < 16) {
          ((float*)(ws + OFF_MV))[r * 512 + (g - 8) * 64 + l] = val;
        } else if (g < 18) {
          float c, s; rope_cs(r, l & 31, c, s);
          const float other = outb[r * 64 + (l ^ 32)];
          const float y = (l < 32) ? val * c - other * s : val * c + other * s;
          ((u16*)(ws + OFF_AK))[r * 128 + (g - 16) * 64 + l] = f2bf(y);
        } else {
          ((u16*)(ws + OFF_AV))[r * 128 + (g - 18) * 64 + l] = f2bf(val);
        }
      }
      __syncthreads();
    }
  }
}

constexpr int HST = 136;

DEVI void load_vt(const u16* __restrict__ hv, size_t R0, int h, u16* Vt) {
  const int tid = opaque_tid();
  const int d = tid & 127, seg = tid >> 7;
  unsigned vv[32];
#pragma unroll
  for (int i = 0; i < 32; ++i) vv[i] = hv[(R0 + seg * 32 + i) * 512 + h * 128 + d];
#pragma unroll
  for (int i = 0; i < 32; i += 2) *(unsigned*)(Vt + d * HST + seg * 32 + i) = vv[i] | (vv[i + 1] << 16);
}

DEVI void hgrn_local(const Params& p, int mt, char* smem) {
  const int tid = opaque_tid(), wid = tid >> 6, lane = tid & 63, fr = lane & 15, fq = lane >> 4;
  char* ws = opaque_ptr(p.ws);
  u16* At = (u16*)smem;
  u16* Vt = (u16*)(smem + 128 * HST * 2);
  float* tot = (float*)(smem + 2 * 128 * HST * 2);
  const float* logf = (const float*)(ws + OFF_GL + (size_t)mt * GL_BLOCK + GL_LOGF);
  const u16* hv = (const u16*)(ws + OFF_HV);
  float* U = p.out;
  float* dvec = (float*)(ws + OFF_DVEC);
#pragma unroll 1
  for (int un = 0; un < 8; ++un) {
    const int cl = un >> 2, h = un & 3;
    const size_t R0 = (size_t)mt * 256 + cl * 128;
    const int u = (mt * 2 + cl) * 4 + h;
    const int k = tid & 127, seg = tid >> 7;
    const float* lfp = logf + (cl * 128 + seg * 32) * 512 + h * 128 + k;
    float lf[32];
#pragma unroll
    for (int i = 0; i < 32; ++i) lf[i] = lfp[i * 512];
    load_vt(hv, R0, h, Vt);
    float T = 0.f;
#pragma unroll
    for (int i = 0; i < 32; ++i) T += lf[i];
    tot[seg * 128 + k] = T;
    __syncthreads();
    float run = 0.f;
#pragma unroll
    for (int s2 = 3; s2 >= 1; --s2) if (s2 > seg) run += tot[s2 * 128 + k];
#pragma unroll
    for (int i = 31; i >= 1; i -= 2) {
      const float l1 = lf[i], l0 = lf[i - 1];
      const float a1 = (1.0f - __expf(l1)) * __expf(run);
      run += l1;
      const float a0 = (1.0f - __expf(l0)) * __expf(run);
      run += l0;
      *(unsigned*)(At + k * HST + seg * 32 + i - 1) = pack2(a0, a1);
    }
    if (seg == 0) dvec[(size_t)u * 128 + k] = __expf(run);
    __syncthreads();
    f32x4 acc[8];
#pragma unroll
    for (int j = 0; j < 8; ++j) acc[j] = f32x4{0.f, 0.f, 0.f, 0.f};
#pragma unroll
    for (int ks = 0; ks < 4; ++ks) {
      const bf16x8 a = *(const bf16x8*)(Vt + (wid * 16 + fr) * HST + ks * 32 + fq * 8);
#pragma unroll
      for (int j = 0; j < 8; ++j) {
        const bf16x8 b = *(const bf16x8*)(At + (j * 16 + fr) * HST + ks * 32 + fq * 8);
        acc[j] = __builtin_amdgcn_mfma_f32_16x16x32_bf16(a, b, acc[j], 0, 0, 0);
      }
    }
    float* Uu = U + (size_t)u * 16384;
#pragma unroll
    for (int j = 0; j < 8; ++j)
#pragma unroll
      for (int r = 0; r < 4; ++r) Uu[(wid * 16 + fq * 4 + r) * 128 + j * 16 + fr] = acc[j][r];
    __syncthreads();
  }
}

DEVI void hgrn_scan(const Params& p) {
  char* ws = opaque_ptr(p.ws);
  const float* mlogf = (const float*)(ws + OFF_MLOGF);
  const float* mv = (const float*)(ws + OFF_MV);
  const float* U = p.out;
  const float* dvec = (const float*)(ws + OFF_DVEC);
  for (int idx = blockIdx.x * NT + opaque_tid(); idx < 131072; idx += gridDim.x * NT) {
    const int k4 = idx & 31, v = (idx >> 5) & 127, bh = idx >> 12, b = bh >> 2, h = bh & 3;
    float S[4] = {0.f, 0.f, 0.f, 0.f};
    float run[4] = {0.f, 0.f, 0.f, 0.f};
#pragma unroll
    for (int j = 15; j >= 0; --j) {
      const float4 lf = *(const float4*)(mlogf + j * 512 + h * 128 + k4 * 4);
      const float vv = mv[j * 512 + h * 128 + v];
      S[0] += (1.0f - __expf(lf.x)) * __expf(run[0]) * vv; run[0] += lf.x;
      S[1] += (1.0f - __expf(lf.y)) * __expf(run[1]) * vv; run[1] += lf.y;
      S[2] += (1.0f - __expf(lf.z)) * __expf(run[2]) * vv; run[2] += lf.z;
      S[3] += (1.0f - __expf(lf.w)) * __expf(run[3]) * vv; run[3] += lf.w;
    }
#pragma unroll 8
    for (int c = 0; c < 64; ++c) {
      const int gc = b * 64 + c;
      const int u = gc * 4 + h;
      const int mt = gc >> 1, cl = gc & 1;
      u16* dst = (u16*)(ws + OFF_R1 + (size_t)mt * 524288) + ((cl * 4 + h) * 16384 + v * 128 + k4 * 4);
      uint2 o; o.x = pack2(S[0], S[1]); o.y = pack2(S[2], S[3]);
      *(uint2*)dst = o;
      const float4 uu = *(const float4*)(U + (size_t)u * 16384 + v * 128 + k4 * 4);
      const float4 dd = *(const float4*)(dvec + (size_t)u * 128 + k4 * 4);
      S[0] = dd.x * S[0] + uu.x; S[1] = dd.y * S[1] + uu.y; S[2] = dd.z * S[2] + uu.z; S[3] = dd.w * S[3] + uu.w;
    }
  }
}

DEVI void hgrn_out(const Params& p, int mt, char* smem) {
  const int tid = opaque_tid(), wid = tid >> 6, lane = tid & 63, fr = lane & 15, fq = lane >> 4;
  char* ws = opaque_ptr(p.ws);
  u16* Qb = (u16*)smem;
  u16* Q1 = Qb + 128 * HST;
  u16* K0 = Q1 + 64 * HST;
  u16* K1 = K0 + 64 * HST;
  u16* Vt = K1 + 128 * HST;
  float* tot = (float*)(Vt + 128 * HST);
  const float* logf = (const float*)(ws + OFF_GL + (size_t)mt * GL_BLOCK + GL_LOGF);
  const u16* hq = (const u16*)(ws + OFF_HQ);
  const u16* hv = (const u16*)(ws + OFF_HV);
  const u16* hg = (const u16*)(ws + OFF_HG);
  u16* ho = (u16*)(ws + OFF_HO);
#pragma unroll 1
  for (int un = 0; un < 8; ++un) {
    const int cl = un >> 2, h = un & 3;
    const size_t R0 = (size_t)mt * 256 + cl * 128;
    const u16* St = (const u16*)(ws + OFF_R1 + (size_t)mt * 524288) + (cl * 4 + h) * 16384;
    bf16x8 sb[2][8];
    {
      const int k = tid & 127, seg = tid >> 7;
      const float* lfp = logf + (cl * 128 + seg * 32) * 512 + h * 128 + k;
      const u16* qp_ = hq + (R0 + seg * 32) * 512 + h * 128 + k;
      float lf[32]; unsigned qr[32];
#pragma unroll
      for (int i = 0; i < 32; ++i) { lf[i] = lfp[i * 512]; qr[i] = qp_[i * 512]; }
#pragma unroll
      for (int ks = 0; ks < 2; ++ks)
#pragma unroll
        for (int j = 0; j < 8; ++j) sb[ks][j] = *(const bf16x8*)(St + (j * 16 + fr) * 128 + ks * 32 + fq * 8);
      load_vt(hv, R0, h, Vt);
      float T = 0.f;
#pragma unroll
      for (int i = 0; i < 32; ++i) T += lf[i];
      tot[seg * 128 + k] = T;
      __syncthreads();
      float run = 0.f;
#pragma unroll
      for (int s2 = 0; s2 < 3; ++s2) if (s2 < seg) run += tot[s2 * 128 + k];
      const float r1 = tot[k] + tot[128 + k];
      const bool hi = seg >= 2;
      u16* xdst = hi ? (Q1 + (seg * 32 - 64) * HST + k) : (K0 + (seg * 32) * HST + k);
#pragma unroll
      for (int i = 0; i < 32; ++i) {
        const int t = seg * 32 + i;
        const float l = lf[i];
        run += l;
        const float qv = __uint_as_float(qr[i] << 16);
        const float kk = 1.0f - __expf(l);
        Qb[t * HST + k] = f2bf(qv * __expf(run));
        K1[t * HST + k] = f2bf(kk * __expf(r1 - run));
        xdst[i * HST] = f2bf((hi ? qv : kk) * __expf(hi ? (run - r1) : -run));
      }
    }
    __syncthreads();
    f32x4 acc[8];
#pragma unroll
    for (int j = 0; j < 8; ++j) acc[j] = f32x4{0.f, 0.f, 0.f, 0.f};
    {
      bf16x8 sc[2][8];
#pragma unroll
      for (int ks = 0; ks < 2; ++ks)
#pragma unroll
        for (int j = 0; j < 8; ++j) sc[ks][j] = *(const bf16x8*)(St + (j * 16 + fr) * 128 + (ks + 2) * 32 + fq * 8);
#pragma unroll
      for (int ks = 0; ks < 2; ++ks) {
        const bf16x8 a = *(const bf16x8*)(Qb + (wid * 16 + fr) * HST + ks * 32 + fq * 8);
#pragma unroll
        for (int j = 0; j < 8; ++j) acc[j] = __builtin_amdgcn_mfma_f32_16x16x32_bf16(a, sb[ks][j], acc[j], 0, 0, 0);
      }
#pragma unroll
      for (int ks = 0; ks < 2; ++ks) {
        const bf16x8 a = *(const bf16x8*)(Qb + (wid * 16 + fr) * HST + (ks + 2) * 32 + fq * 8);
#pragma unroll
        for (int j = 0; j < 8; ++j) acc[j] = __builtin_amdgcn_mfma_f32_16x16x32_bf16(a, sc[ks][j], acc[j], 0, 0, 0);
      }
    }
    {
      const int H = wid >> 2;
      const u16* Qsrc = H ? (Q1 + ((wid - 4) * 16 + fr) * HST) : (Qb + (wid * 16 + fr) * HST);
      const u16* Ksrc = H ? K1 : K0;
      bf16x8 qf[4];
      bf16x4 vlo[8], vhi[8];
#pragma unroll
      for (int ks = 0; ks < 4; ++ks) qf[ks] = *(const bf16x8*)(Qsrc + ks * 32 + fq * 8);
#pragma unroll
      for (int g = 0; g < 4; ++g) {
        if (2 * g <= wid) {
          f32x4 s0 = f32x4{0.f, 0.f, 0.f, 0.f}, s1 = f32x4{0.f, 0.f, 0.f, 0.f};
          {
            bf16x8 ka[4], kb[4];
            const bool two = (2 * g + 1 <= wid);
#pragma unroll
            for (int ks = 0; ks < 4; ++ks) {
              ka[ks] = *(const bf16x8*)(Ksrc + ((2 * g) * 16 + fr) * HST + ks * 32 + fq * 8);
              kb[ks] = *(const bf16x8*)(Ksrc + ((two ? 2 * g + 1 : 2 * g) * 16 + fr) * HST + ks * 32 + fq * 8);
            }
#pragma unroll
            for (int j = 0; j < 8; ++j) {
              const u16* vp = Vt + (j * 16 + fr) * HST + g * 32 + fq * 4;
              vlo[j] = *(const bf16x4*)vp; vhi[j] = *(const bf16x4*)(vp + 16);
            }
#pragma unroll
            for (int ks = 0; ks < 4; ++ks) s0 = __builtin_amdgcn_mfma_f32_16x16x32_bf16(ka[ks], qf[ks], s0, 0, 0, 0);
#pragma unroll
            for (int ks = 0; ks < 4; ++ks) s1 = __builtin_amdgcn_mfma_f32_16x16x32_bf16(kb[ks], qf[ks], s1, 0, 0, 0);
            if (!two) s1 = f32x4{0.f, 0.f, 0.f, 0.f};
          }
          if (2 * g == wid) {
#pragma unroll
            for (int r = 0; r < 4; ++r) if (fq * 4 + r > fr) s0[r] = 0.f;
          }
          if (2 * g + 1 == wid) {
#pragma unroll
            for (int r = 0; r < 4; ++r) if (fq * 4 + r > fr) s1[r] = 0.f;
          }
          bf16x8 pf;
          pf[0] = (short)f2bf(s0[0]); pf[1] = (short)f2bf(s0[1]); pf[2] = (short)f2bf(s0[2]); pf[3] = (short)f2bf(s0[3]);
          pf[4] = (short)f2bf(s1[0]); pf[5] = (short)f2bf(s1[1]); pf[6] = (short)f2bf(s1[2]); pf[7] = (short)f2bf(s1[3]);
#pragma unroll
          for (int j = 0; j < 8; ++j) {
            bf16x8 b;
            b[0] = vlo[j][0]; b[1] = vlo[j][1]; b[2] = vlo[j][2]; b[3] = vlo[j][3]; b[4] = vhi[j][0]; b[5] = vhi[j][1]; b[6] = vhi[j][2]; b[7] = vhi[j][3];
            acc[j] = __builtin_amdgcn_mfma_f32_16x16x32_bf16(pf, b, acc[j], 0, 0, 0);
          }
        }
      }
    }
    {
      float ss[4];
#pragma unroll
      for (int r = 0; r < 4; ++r) {
        float s = 0.f;
#pragma unroll
        for (int j = 0; j < 8; ++j) s += acc[j][r] * acc[j][r];
        s += __shfl_xor(s, 1); s += __shfl_xor(s, 2); s += __shfl_xor(s, 4); s += __shfl_xor(s, 8);
        ss[r] = rsqrtf(s * (1.0f / 128.0f) + EPSF);
      }
#pragma unroll
      for (int j = 0; j < 8; ++j) {
        const float ng = p.hgng[j * 16 + fr];
#pragma unroll
        for (int r = 0; r < 4; ++r) {
          const size_t off = (R0 + wid * 16 + fq * 4 + r) * 512 + h * 128 + j * 16 + fr;
          ho[blk(512, mt, cl * 128 + wid * 16 + fq * 4 + r, h * 128 + j * 16 + fr)] = f2bf(acc[j][r] * ss[r] * ng * bf2f(hg[off]));
        }
      }
    }
    __syncthreads();
  }
}

constexpr int KST = 72;
constexpr int VST = 296;
DEVI void attention(const Params& p, int mt, char* smem) {
  const int tid = opaque_tid(), wid = tid >> 6, lane = tid & 63, fr = lane & 15, fq = lane >> 4;
  char* ws = opaque_ptr(p.ws);
  u16* Ks = (u16*)smem;
  u16* Vt = (u16*)(smem + 272 * KST * 2);
  const u16* aq = (const u16*)(ws + OFF_AQ);
  const u16* ak = (const u16*)(ws + OFF_AK);
  const u16* av = (const u16*)(ws + OFF_AV);
  u16* ao = (u16*)(ws + OFF_AO);
#pragma unroll 1
  for (int un = 0; un < 4; ++un) {
    const int cl = un >> 1, kvh = un & 1;
    const size_t R0 = (size_t)mt * 256 + cl * 128;
    const bool has_prev = (R0 & 8191) != 0;
    auto krow_of = [&](int kk) -> size_t {
      if (kk < 16) return (size_t)kk;
      if (kk < 144) return has_prev ? (16 + R0 - 128 + (kk - 16)) : (16 + R0 + (kk - 16));
      return 16 + R0 + (kk - 144);
    };
#pragma unroll
    for (int it = 0; it < 5; ++it) {
      const int i = it * NT + tid;
      if (i >= 272 * 8) break;
      const int kk = i >> 3, ch = i & 7;
      const uint4 kv = *(const uint4*)(ak + krow_of(kk) * 128 + kvh * 64 + ch * 8);
      *(uint4*)(Ks + kk * KST + ch * 8) = kv;
    }
#pragma unroll
    for (int it = 0; it < 3; ++it) {
      const int i = it * NT + tid;
      if (i >= 136 * 8) break;
      const int kp = i % 136, ch = i / 136;
      const uint4 v0 = *(const uint4*)(av + krow_of(2 * kp) * 128 + kvh * 64 + ch * 8);
      const uint4 v1 = *(const uint4*)(av + krow_of(2 * kp + 1) * 128 + kvh * 64 + ch * 8);
      unsigned* vd = (unsigned*)(Vt + (ch * 8) * VST + 2 * kp);
      constexpr int VS2 = VST / 2;
      vd[0 * VS2] = (v0.x & 0xffffu) | (v1.x << 16); vd[1 * VS2] = (v0.x >> 16) | (v1.x & 0xffff0000u);
      vd[2 * VS2] = (v0.y & 0xffffu) | (v1.y << 16); vd[3 * VS2] = (v0.y >> 16) | (v1.y & 0xffff0000u);
      vd[4 * VS2] = (v0.z & 0xffffu) | (v1.z << 16); vd[5 * VS2] = (v0.z >> 16) | (v1.z & 0xffff0000u);
      vd[6 * VS2] = (v0.w & 0xffffu) | (v1.w << 16); vd[7 * VS2] = (v0.w >> 16) | (v1.w & 0xffff0000u);
    }
    __syncthreads();
    const int qt = wid;
    const int iq = qt * 16 + fr;
    const int lo = has_prev ? (iq + 1) : max(iq + 1, 128);
    const unsigned hi_lo = (unsigned)(iq + 128 - lo);
#pragma unroll 1
    for (int g = 0; g < 4; ++g) {
      asm volatile("" ::: "memory");
      const int hq = kvh * 4 + g;
      const float sink = p.sinks[hq];
      const u16* qp = aq + (R0 + qt * 16 + fr) * 512 + hq * 64 + fq * 8;
      const bf16x8 qf0 = *(const bf16x8*)qp;
      const bf16x8 qf1 = *(const bf16x8*)(qp + 32);
      f32x4 sT[10];
#pragma unroll
      for (int ih = 0; ih < 2; ++ih) {
        bf16x8 k0[5], k1[5];
#pragma unroll
        for (int ii = 0; ii < 5; ++ii) {
          const int i = ih * 5 + ii;
          const int krow = (i < 9) ? (16 + (qt + i) * 16) : 0;
          const u16* kp = Ks + (krow + fr) * KST + fq * 8;
          k0[ii] = *(const bf16x8*)kp; k1[ii] = *(const bf16x8*)(kp + 32);
        }
#pragma unroll
        for (int ii = 0; ii < 5; ++ii) {
          f32x4 s = f32x4{0.f, 0.f, 0.f, 0.f};
          s = __builtin_amdgcn_mfma_f32_16x16x32_bf16(k0[ii], qf0, s, 0, 0, 0);
          s = __builtin_amdgcn_mfma_f32_16x16x32_bf16(k1[ii], qf1, s, 0, 0, 0);
          sT[ih * 5 + ii] = s;
        }
      }
      float m = sink;
#pragma unroll
      for (int i = 0; i < 9; ++i)
#pragma unroll
        for (int r = 0; r < 4; ++r) {
          if (i == 0 || i == 8 || !has_prev) {
            const int jb = (qt + i) * 16 + fq * 4 + r;
            const bool ok = (unsigned)(jb - lo) <= hi_lo;
            sT[i][r] = ok ? sT[i][r] : -3.0e38f;
          }
          m = fmaxf(m, sT[i][r]);
        }
#pragma unroll
      for (int r = 0; r < 4; ++r) m = fmaxf(m, sT[9][r]);
      m = fmaxf(m, __shfl_xor(m, 16)); m = fmaxf(m, __shfl_xor(m, 32));
      float l = 0.f;
#pragma unroll
      for (int i = 0; i < 10; ++i)
#pragma unroll
        for (int r = 0; r < 4; ++r) {
          const float e = __expf(sT[i][r] - m);
          sT[i][r] = e; l += e;
        }
      l += __shfl_xor(l, 16); l += __shfl_xor(l, 32);
      l += __expf(sink - m);
      const float linv = 1.0f / l;
      f32x4 o[4];
#pragma unroll
      for (int dt = 0; dt < 4; ++dt) o[dt] = f32x4{0.f, 0.f, 0.f, 0.f};
#pragma unroll
      for (int gp = 0; gp < 5; ++gp) {
        const int ia = 2 * gp, ib = 2 * gp + 1;
        const int krowa = 16 + (qt + ia) * 16;
        const int krowb = (ib < 9) ? (16 + (qt + ib) * 16) : 0;
        bf16x8 pf;
        pf[0] = (short)f2bf(sT[ia][0]); pf[1] = (short)f2bf(sT[ia][1]); pf[2] = (short)f2bf(sT[ia][2]); pf[3] = (short)f2bf(sT[ia][3]);
        pf[4] = (short)f2bf(sT[ib][0]); pf[5] = (short)f2bf(sT[ib][1]); pf[6] = (short)f2bf(sT[ib][2]); pf[7] = (short)f2bf(sT[ib][3]);
        bf16x4 v0[4], v1[4];
#pragma unroll
        for (int dt = 0; dt < 4; ++dt) {
          const u16* vp = Vt + (dt * 16 + fr) * VST + fq * 4;
          v0[dt] = *(const bf16x4*)(vp + krowa); v1[dt] = *(const bf16x4*)(vp + krowb);
        }
#pragma unroll
        for (int dt = 0; dt < 4; ++dt) {
          bf16x8 b;
          b[0] = v0[dt][0]; b[1] = v0[dt][1]; b[2] = v0[dt][2]; b[3] = v0[dt][3]; b[4] = v1[dt][0]; b[5] = v1[dt][1]; b[6] = v1[dt][2]; b[7] = v1[dt][3];
          o[dt] = __builtin_amdgcn_mfma_f32_16x16x32_bf16(pf, b, o[dt], 0, 0, 0);
        }
      }
#pragma unroll
      for (int r = 0; r < 4; ++r) {
        const float li = __shfl(linv, fq * 4 + r);
#pragma unroll
        for (int dt = 0; dt < 4; ++dt)
          ao[blk(512, mt, cl * 128 + qt * 16 + fq * 4 + r, hq * 64 + dt * 16 + fr)] = f2bf(o[dt][r] * li);
      }
    }
    __syncthreads();
  }
}

DEVI bool unit_of(int i, int nN, int& pm, int& pn) {
  const int nwg = NTILE * nN;
  const int L = i * (int)gridDim.x + (int)blockIdx.x;
  if (L >= nwg) return false;
  const int q = nwg >> 3;
  const int wgid = (L & 7) * q + (L >> 3);
  const int nig = 8 * nN, gid = wgid / nig, rem = wgid - gid * nig;
  pm = gid * 8 + (rem & 7); pn = rem >> 3;
  return true;
}
DEVI int units_of(int nN) { const int nwg = NTILE * nN; const int c = blockIdx.x, G = gridDim.x; return c < nwg ? (nwg - c + G - 1) / G : 0; }

__global__ void __launch_bounds__(NT, 2) fwd_megakernel(Params p) {
  extern __shared__ __attribute__((aligned(16))) char smem[];
  cg::grid_group grid = cg::this_grid();
  for (int ph = p.ph_lo; ph < p.ph_hi; ++ph) {
    if (ph > p.ph_lo) grid.sync();
    char* ws = opaque_ptr(p.ws);
    if (ph == 0) {
      for (int r_ = 0; r_ < PROBE_A; ++r_) { phase0(p, smem); __syncthreads(); }
    } else if (ph == 1) {
      for (int rep_ = 0; rep_ < PROBE_P1; ++rep_) {
      const char* h0b = (const char*)p.out + DOUT_H0;
      const char* wint = ws + OFF_WINT;
      gemm_stream<1024>(units_of(19),
        [&](int i, const char*& A, const char*& B) { int pm, pn; unit_of(i, 19, pm, pn); A = h0b + (size_t)pm * 256 * 1024 * 2; B = wint + (size_t)pn * 256 * 1024 * 2; },
        [&](int i, const f32x4 (&acc)[2][2][4][2], int wr, int wc, int fr, int fq) {
          int mt, nt; unit_of(i, 19, mt, nt);
          char* w2 = opaque_ptr(p.ws);
          if (nt == 2 || nt == 3) epi_regs<EPI_F>(p, mt, nt, acc, wr, wc, fr, fq);
          else if (nt == 8 || nt == 9) epi_regs<EPI_AQ>(p, mt, nt, acc, wr, wc, fr, fq);
          else if (nt == 10) epi_regs<EPI_AKV>(p, mt, nt, acc, wr, wc, fr, fq);
          else {
            int mode, dstride, dcol; u16* dstb;
            if (nt < 2) { mode = 1; dstb = (u16*)(w2 + OFF_HQ) + (size_t)mt * 256 * 512; dstride = 512; dcol = nt * 256; }
            else if (nt < 6) { mode = 0; dstb = (u16*)(w2 + OFF_HV) + (size_t)mt * 256 * 512; dstride = 512; dcol = (nt - 4) * 256; }
            else if (nt < 8) { mode = 1; dstb = (u16*)(w2 + OFF_HG) + (size_t)mt * 256 * 512; dstride = 512; dcol = (nt - 6) * 256; }
            else { mode = 2; dstb = (u16*)(w2 + OFF_GL + (size_t)mt * GL_BLOCK); dstride = 2048; dcol = (nt - 11) * 256; }
            epi_regs<EPI_ACT>(p, mt, nt, acc, wr, wc, fr, fq, mode, dstb, dstride, dcol);
          }
        }, smem);
      __syncthreads();
      }
    } else if (ph == 2) {
      for (int r_ = 0; r_ < PROBE_B; ++r_)
      for (int mt = blockIdx.x; mt < NTILE; mt += gridDim.x) {
        __syncthreads();
        attention(p, mt, smem);
        hgrn_local(p, mt, smem);
      }
    } else if (ph == 3) {
      for (int r_ = 0; r_ < PROBE_C; ++r_) hgrn_scan(p);
    } else if (ph == 4) {
      for (int mt = blockIdx.x; mt < NTILE; mt += gridDim.x) {
        __syncthreads();
        for (int r_ = 0; r_ < PROBE_D; ++r_) hgrn_out(p, mt, smem);
        __syncthreads();
        {
          const char* ao = ws + OFF_AO + (size_t)mt * 256 * 512 * 2; const char* ho = ws + OFF_HO + (size_t)mt * 256 * 512 * 2;
          const char* wa = ws + OFF_WBATT; const char* wh = ws + OFF_WBHG;
          gemm_stream<512>(8,
            [&](int i, const char*& A, const char*& B) { A = (i & 1) ? ho : ao; B = ((i & 1) ? wh : wa) + (size_t)(i >> 1) * 256 * 512 * 2; },
            [&](int i, const f32x4 (&acc)[2][2][4][2], int wr, int wc, int fr, int fq) {
              if (i & 1) epi_regs<EPI_HG>(p, mt, i >> 1, acc, wr, wc, fr, fq); else epi_regs<EPI_ATT>(p, mt, i >> 1, acc, wr, wc, fr, fq);
            }, smem);
        }
        __syncthreads();
        const char* r1 = ws + OFF_R1 + (size_t)mt * 256 * 1024 * 2;
        {
          const char* wo = ws + OFF_WOUT;
          gemm_stream<1024>(4,
            [&](int i, const char*& A, const char*& B) { A = r1; B = wo + (size_t)i * 256 * 1024 * 2; },
            [&](int i, const f32x4 (&acc)[2][2][4][2], int wr, int wc, int fr, int fq) { epi_regs<EPI_OUT>(p, mt, i, acc, wr, wc, fr, fq); }, smem);
        }
        __syncthreads();
        ln_rows(p, mt, p.ln1g, p.ln1b, (u16*)(ws + OFF_R1));
        __syncthreads();
        {
          const char* wf = ws + OFF_WFI;
          gemm_stream<1024>(22,
            [&](int i, const char*& A, const char*& B) { A = r1; B = wf + (size_t)i * 256 * 1024 * 2; },
            [&](int i, const f32x4 (&acc)[2][2][4][2], int wr, int wc, int fr, int fq) { epi_regs<EPI_FFI>(p, mt, i, acc, wr, wc, fr, fq); }, smem);
        }
        __syncthreads();
        {
          const char* glb = ws + OFF_GL + (size_t)mt * GL_BLOCK; const char* wf = ws + OFF_WFO;
          gemm_stream<DFF>(4,
            [&](int i, const char*& A, const char*& B) { A = glb; B = wf + (size_t)i * 256 * DFF * 2; },
            [&](int i, const f32x4 (&acc)[2][2][4][2], int wr, int wc, int fr, int fq) { epi_regs<EPI_FFO>(p, mt, i, acc, wr, wc, fr, fq); }, smem);
        }
        __syncthreads();
        ln_rows(p, mt, p.ln2g, p.ln2b, nullptr);
      }
    }
  }
}

extern "C" void kernel_launch(void* const* d_in, const int* in_sizes, int n_in, void* d_out, int out_size, void* d_ws, size_t ws_size,
                              hipStream_t stream) {
  static int grid_blocks = 0;
  if (!grid_blocks) {
    if (ws_size < WS_END) { fprintf(stderr, "kernel_launch: workspace too small: %zu < %zu\n", ws_size, (size_t)WS_END); grid_blocks = -1; return; }
    int dev = 0, cus = 0, per_cu = 0;
    hipGetDevice(&dev);
    hipDeviceGetAttribute(&cus, hipDeviceAttributeMultiprocessorCount, dev);
    if (hipFuncSetAttribute((const void*)fwd_megakernel, hipFuncAttributeMaxDynamicSharedMemorySize, LDS_BYTES) != hipSuccess)
      fprintf(stderr, "kernel_launch: hipFuncSetAttribute failed\n");
    hipOccupancyMaxActiveBlocksPerMultiprocessor(&per_cu, (const void*)fwd_megakernel, NT, LDS_BYTES);
    if (per_cu < 1) { fprintf(stderr, "kernel_launch: occupancy query says %d blocks/CU\n", per_cu); per_cu = 1; }
    int g = cus * per_cu;
    if (g > NTILE) g = NTILE;
    grid_blocks = g;
  }
  if (grid_blocks < 0) return;
  Params p{};
  p.x = (const float*)d_in[0]; p.meta = (const float*)d_in[1]; p.lng = (const float*)d_in[2]; p.lnb = (const float*)d_in[3];
  p.w_in = (const float*)d_in[4]; p.hglb = (const float*)d_in[5]; p.hgng = (const float*)d_in[6]; p.sinks = (const float*)d_in[7];
  p.w_bhg = (const float*)d_in[8]; p.w_batt = (const float*)d_in[9]; p.w_out = (const float*)d_in[10];
  p.ln1g = (const float*)d_in[11]; p.ln1b = (const float*)d_in[12]; p.w_fi = (const float*)d_in[13]; p.w_fo = (const float*)d_in[14];
  p.ln2g = (const float*)d_in[15]; p.ln2b = (const float*)d_in[16];
  p.out = (float*)d_out; p.ws = (char*)d_ws;
  constexpr int NPHASE = 5;
  int cuts[MK_LAUNCHES + 1];
  for (int li = 0; li <= MK_LAUNCHES; ++li) cuts[li] = (MK_LAUNCHES == 1) ? (li ? NPHASE : 0) : li;
  for (int li = 0; li < MK_LAUNCHES; ++li) {
    p.ph_lo = cuts[li]; p.ph_hi = cuts[li + 1];
    void* args[] = {&p};
    hipError_t e = hipLaunchCooperativeKernel((const void*)fwd_megakernel, dim3(grid_blocks), dim3(NT), args, LDS_BYTES, stream);
    if (e != hipSuccess) { fprintf(stderr, "cooperative launch %d failed: %s (grid %d)\n", li, hipGetErrorString(e), grid_blocks); break; }
  }
}
```

```cpp
#include <hip/hip_runtime.h>
#include <hip/hip_cooperative_groups.h>
#include <cstdio>
namespace cg = cooperative_groups;

#ifndef PROBE_A
#define PROBE_A 1
#endif
#ifndef PROBE_B
#define PROBE_B 1
#endif
#ifndef PROBE_C
#define PROBE_C 1
#endif
#ifndef PROBE_D
#define PROBE_D 1
#endif
#ifndef PROBE_P1
#define PROBE_P1 1
#endif
#ifndef REP_P0
#define REP_P0 1
#endif
#ifndef REP_G1
#define REP_G1 1
#endif
#ifndef REP_MIX
#define REP_MIX 1
#endif
#ifndef REP_SC
#define REP_SC 1
#endif
#ifndef MK_LAUNCHES
#define MK_LAUNCHES 1
#endif

#define DEVI __device__ __forceinline__
typedef unsigned short u16;
using bf16x8 = __attribute__((ext_vector_type(8))) short;
using bf16x4 = __attribute__((ext_vector_type(4))) short;
using f32x4 = __attribute__((ext_vector_type(4))) float;

constexpr int NT = 512;
constexpr int ROWS = 65536;
constexpr int NTILE = 256;
constexpr int INW = 4864;
constexpr int DFF = 2816;
constexpr float EPSF = 1e-5f;
constexpr float ALPHA = 1.189207115002721f;

constexpr size_t OFF_WINT  = 0;
constexpr size_t OFF_WBHG  = OFF_WINT  + (size_t)INW * 1024 * 2;
constexpr size_t OFF_WBATT = OFF_WBHG  + (size_t)1024 * 512 * 2;
constexpr size_t OFF_WOUT  = OFF_WBATT + (size_t)1024 * 512 * 2;
constexpr size_t OFF_WFI   = OFF_WOUT  + (size_t)1024 * 1024 * 2;
constexpr size_t OFF_WFO   = OFF_WFI   + (size_t)2 * DFF * 1024 * 2;
constexpr size_t OFF_STATS = OFF_WFO   + (size_t)1024 * DFF * 2;
constexpr size_t OFF_ROPE  = OFF_STATS + (size_t)ROWS * 2 * 4;
constexpr size_t OFF_MLOGF = OFF_ROPE  + (size_t)8208 * 32 * 2 * 4;
constexpr size_t OFF_MV    = OFF_MLOGF + (size_t)16 * 512 * 4;
constexpr size_t OFF_STATS2= OFF_MV    + (size_t)16 * 512 * 4;
constexpr size_t OFF_DVEC  = OFF_STATS2+ (size_t)ROWS * 2 * 4;
constexpr size_t OFF_R1    = OFF_DVEC  + (size_t)2048 * 128 * 4;
constexpr size_t OFF_HQ    = OFF_R1    + (size_t)ROWS * 1024 * 2;
constexpr size_t OFF_HV    = OFF_HQ    + (size_t)ROWS * 512 * 2;
constexpr size_t OFF_HG    = OFF_HV    + (size_t)ROWS * 512 * 2;
constexpr size_t OFF_AQ    = OFF_HG    + (size_t)ROWS * 512 * 2;
constexpr size_t OFF_AK    = OFF_AQ    + (size_t)ROWS * 512 * 2;
constexpr size_t OFF_AV    = OFF_AK    + (size_t)(ROWS + 16) * 128 * 2;
constexpr size_t OFF_GL    = OFF_AV    + (size_t)(ROWS + 16) * 128 * 2;
constexpr size_t GL_BLOCK  = (size_t)256 * 2048 * 2 + (size_t)256 * 512 * 4;
constexpr size_t GL_LOGF   = (size_t)256 * 2048 * 2;
constexpr size_t OFF_HO    = OFF_GL    + (size_t)NTILE * GL_BLOCK;
constexpr size_t OFF_AO    = OFF_HO    + (size_t)ROWS * 512 * 2;
constexpr size_t WS_END    = OFF_AO    + (size_t)ROWS * 512 * 2;
constexpr size_t DOUT_H0   = (size_t)2048 * 128 * 128 * 4;

constexpr int LDS_BYTES = 144 * 1024;

struct Params {
  const float *x, *meta, *lng, *lnb, *w_in, *hglb, *hgng, *sinks, *w_bhg, *w_batt, *w_out, *ln1g, *ln1b, *w_fi, *w_fo, *ln2g, *ln2b;
  float* out;
  char* ws;
  int ph_lo, ph_hi;
};

typedef __bf16 bf16x2_t __attribute__((ext_vector_type(2)));
typedef float f32x2_t __attribute__((ext_vector_type(2)));
DEVI unsigned pack2(float a, float b) { f32x2_t v = {a, b}; bf16x2_t r = __builtin_convertvector(v, bf16x2_t); return __builtin_bit_cast(unsigned, r); }
DEVI u16 f2bf(float f) { return (u16)(pack2(f, 0.f) & 0xffffu); }
DEVI float bf2f(u16 h) { return __uint_as_float(((unsigned)h) << 16); }
DEVI float bflo(unsigned w) { return __uint_as_float(w << 16); }
DEVI float bfhi(unsigned w) { return __uint_as_float(w & 0xffff0000u); }
DEVI float sigm(float x) { return __builtin_amdgcn_rcpf(1.0f + __expf(-x)); }
DEVI float silu(float x) { return x * sigm(x); }
DEVI float wave_sum(float v) {
#pragma unroll
  for (int o = 32; o; o >>= 1) v += __shfl_xor(v, o);
  return v;
}
DEVI float lb_of(const Params& p, int j) { return 1.0f / (1.0f + __expf(p.hglb[512 + j] - p.hglb[j])); }

DEVI size_t opaque_zero() { size_t z = 0; asm volatile("" : "+s"(z)); return z; }
DEVI char* opaque_ptr(char* q) { return q + opaque_zero(); }
DEVI int opaque_tid() { int t = threadIdx.x; asm volatile("" : "+v"(t)); return t; }

DEVI void rope_cs(int pos, int fi, float& c, float& s) {
  double invd = 1.0;
  if (fi & 1) invd *= 0.7498942093324559;
  if (fi & 2) invd *= 0.5623413251903491;
  if (fi & 4) invd *= 0.31622776601683794;
  if (fi & 8) invd *= 0.1;
  if (fi & 16) invd *= 0.01;
  float inv = (float)invd;
  float ang = (float)pos * inv;
  double a = (double)ang;
  double n = rint(a * 0.15915494309189535);
  double r = fma(-n, 6.283185307179586, a);
  r = fma(-n, 2.4492935982947064e-16, r);
  double r2 = r * r, ts = r, tc = 1.0, ss = r, cc = 1.0;
#pragma unroll
  for (int i = 1; i <= 12; ++i) {
    tc *= -r2 / (double)((2 * i - 1) * (2 * i)); cc += tc;
    ts *= -r2 / (double)((2 * i) * (2 * i + 1)); ss += ts;
  }
  c = (float)cc; s = (float)ss;
}

DEVI void stage_rc(int b, int& R, int& C) {
  int st = b / 1024, sb = b % 1024, swz = sb ^ (((sb >> 9) & 1) << 5);
  R = (st >> 1) * 16 + swz / 64; C = (st & 1) * 32 + (swz % 64) / 2;
}
DEVI int lds_byte(int r, int c) {
  int st = (r >> 4) * 2 + (c >> 5), rr = r & 15, cc = c & 31, ob = rr * 64 + cc * 2;
  return st * 1024 + (ob ^ (((ob >> 9) & 1) << 5));
}

DEVI size_t blk(int K, int tile, int lr, int col) { return (size_t)tile * 256 * K + ((size_t)(col >> 6) * 256 + lr) * 64 + (col & 63); }
DEVI int perm32(int rho) { const int n = rho >> 4, i = rho & 15; return 8 * (i >> 2) + 4 * n + (i & 3); }
DEVI const char* opaque_cptr(const char* q) { return q + opaque_zero(); }

template <int K, class UF, class EF>
DEVI void gemm_stream(const int nunits, UF&& unitf, EF&& epif, char* shm) {
  constexpr int BK = 64, HALF = 128, HTB = HALF * BK * 2;
  if (nunits <= 0) return;
  const int tid = opaque_tid();
  const int wid = tid >> 6, lane = tid & 63, wr = wid >> 2, wc = wid & 3, fr = lane & 15, fq = lane >> 4;
  unsigned voffA0, voffA1, voffB0, voffB1;
  {
    int r0, c0, r1, c1;
    stage_rc(tid * 16, r0, c0); stage_rc(tid * 16 + 8192, r1, c1);
    voffA0 = (unsigned)(r0 * 64 + c0) * 2u; voffA1 = (unsigned)(r1 * 64 + c1) * 2u;
    voffB0 = (unsigned)(((r0 & ~31) + perm32(r0 & 31)) * 64 + c0) * 2u; voffB1 = (unsigned)(((r1 & ~31) + perm32(r1 & 31)) * 64 + c1) * 2u;
  }
  constexpr size_t kstep = (size_t)256 * BK * 2;
  constexpr size_t hstep = (size_t)HALF * BK * 2;
#define SA(b, h) (shm + ((b) * 2 + (h)) * HTB)
#define SB(b, h) (shm + (4 + (b) * 2 + (h)) * HTB)
#define STAGE(P, GBASE, V0, V1) do { const char* _g = opaque_cptr(GBASE); \
    __builtin_amdgcn_global_load_lds((const unsigned*)(_g + (V0)), (unsigned*)((P) + tid * 16), 16, 0, 0); \
    __builtin_amdgcn_global_load_lds((const unsigned*)(_g + (V1)), (unsigned*)((P) + tid * 16 + 8192), 16, 0, 0); } while (0)
#define STAGE_A(P, G) STAGE(P, G, voffA0, voffA1)
#define STAGE_B(P, G) STAGE(P, G, voffB0, voffB1)
#define LDA(dst, b, h) _Pragma("unroll") for (int m = 0; m < 4; ++m) _Pragma("unroll") for (int k = 0; k < 2; ++k) \
    dst[m][k] = *reinterpret_cast<const bf16x8*>(SA(b, h) + lds_byte(wr * 64 + m * 16 + fr, k * 32 + fq * 8))
#define LDB(dst, b, h) _Pragma("unroll") for (int n = 0; n < 2; ++n) _Pragma("unroll") for (int k = 0; k < 2; ++k) \
    dst[n][k] = *reinterpret_cast<const bf16x8*>(SB(b, h) + lds_byte(wc * 32 + n * 16 + fr, k * 32 + fq * 8))
#define MMA(ai, bj, At_, Bt_) do { __builtin_amdgcn_s_setprio(1); \
    _Pragma("unroll") for (int m = 0; m < 4; ++m) _Pragma("unroll") for (int n = 0; n < 2; ++n) _Pragma("unroll") for (int k = 0; k < 2; ++k) \
      acc[ai][bj][m][n] = __builtin_amdgcn_mfma_f32_16x16x32_bf16(Bt_[n][k], At_[m][k], acc[ai][bj][m][n], 0, 0, 0); \
    __builtin_amdgcn_s_setprio(0); } while (0)
#define WAIT_V(n) asm volatile("s_waitcnt vmcnt(" #n ")" ::: "memory")
#define WAIT_L(n) asm volatile("s_waitcnt lgkmcnt(" #n ")" ::: "memory")
#define BAR __builtin_amdgcn_s_barrier()
#define SCHED __builtin_amdgcn_sched_barrier(0)
  f32x4 acc[2][2][4][2];
#pragma unroll
  for (int a = 0; a < 2; ++a)
#pragma unroll
    for (int b = 0; b < 2; ++b)
#pragma unroll
      for (int m = 0; m < 4; ++m)
#pragma unroll
        for (int n = 0; n < 2; ++n) acc[a][b][m][n] = f32x4{0.f, 0.f, 0.f, 0.f};
  bf16x8 At[4][2], B0[2][2], B1[2][2];
  constexpr int nt = K / BK;
  const char* cA; const char* cB;
  unitf(0, cA, cB);
  STAGE_B(SB(0, 0), cB); STAGE_A(SA(0, 0), cA); STAGE_B(SB(0, 1), cB + hstep); STAGE_A(SA(0, 1), cA + hstep);
  if (wr == 1) BAR;
  WAIT_V(4); BAR;
  STAGE_B(SB(1, 0), cB + kstep); STAGE_A(SA(1, 0), cA + kstep); STAGE_B(SB(1, 1), cB + hstep + kstep);
  WAIT_V(6); BAR;
#pragma unroll 1
  for (int ui = 0; ui < nunits; ++ui) {
    const bool has_next = (ui + 1 < nunits);
    const char* nA = cA; const char* nB = cB;
    if (has_next) unitf(ui + 1, nA, nB);
#pragma unroll 1
    for (int t = 0; t < nt; t += 2) {
      const bool last = (t == nt - 2);
      const char* a1 = cA + (size_t)(t + 1) * kstep;
      const char* a2 = last ? nA : cA + (size_t)(t + 2) * kstep;
      const char* b2 = last ? nB : cB + (size_t)(t + 2) * kstep;
      const char* a3 = a2 + kstep; const char* b3 = b2 + kstep;
      LDB(B0, 0, 0); SCHED; LDA(At, 0, 0); STAGE_A(SA(1, 1), a1 + hstep);
      WAIT_L(8); BAR; WAIT_L(0); MMA(0, 0, At, B0); BAR; SCHED;
      LDB(B1, 0, 1); STAGE_B(SB(0, 0), b2);
      BAR; WAIT_L(0); MMA(0, 1, At, B1); BAR;
      LDA(At, 0, 1); STAGE_A(SA(0, 0), a2);
      BAR; WAIT_L(0); MMA(1, 0, At, B0); BAR; SCHED;
      STAGE_B(SB(0, 1), b2 + hstep);
      WAIT_V(6); BAR; MMA(1, 1, At, B1); BAR;
      LDB(B0, 1, 0); SCHED; LDA(At, 1, 0); STAGE_A(SA(0, 1), a2 + hstep);
      WAIT_L(8); BAR; WAIT_L(0); MMA(0, 0, At, B0); BAR; SCHED;
      LDB(B1, 1, 1); STAGE_B(SB(1, 0), b3);
      BAR; WAIT_L(0); MMA(0, 1, At, B1); BAR;
      LDA(At, 1, 1); STAGE_A(SA(1, 0), a3);
      BAR; WAIT_L(0); MMA(1, 0, At, B0); BAR; SCHED;
      STAGE_B(SB(1, 1), b3 + hstep);
      WAIT_V(6); BAR; MMA(1, 1, At, B1); BAR;
    }
    epif(ui, acc, wr, wc, fr, fq);
#pragma unroll
    for (int a = 0; a < 2; ++a)
#pragma unroll
      for (int b = 0; b < 2; ++b)
#pragma unroll
        for (int m = 0; m < 4; ++m)
#pragma unroll
          for (int n = 0; n < 2; ++n) acc[a][b][m][n] = f32x4{0.f, 0.f, 0.f, 0.f};
    cA = nA; cB = nB;
  }
  WAIT_V(0);
  if (wr == 0) BAR;
  BAR;
#undef SA
#undef SB
#undef STAGE
#undef STAGE_A
#undef STAGE_B
#undef LDA
#undef LDB
#undef MMA
}

enum { EPI_ACT = 0, EPI_F, EPI_AQ, EPI_AKV, EPI_ATT, EPI_HG, EPI_OUT, EPI_FFI, EPI_FFO };

DEVI void st_bf8(u16* dst, const float (&y)[8]) {
  uint4 o; o.x = pack2(y[0], y[1]); o.y = pack2(y[2], y[3]); o.z = pack2(y[4], y[5]); o.w = pack2(y[6], y[7]);
  *(uint4*)dst = o;
}
DEVI void ld_bf8(const u16* src, float (&y)[8]) {
  uint4 o = *(const uint4*)src;
  y[0] = bflo(o.x); y[1] = bfhi(o.x); y[2] = bflo(o.y); y[3] = bfhi(o.y); y[4] = bflo(o.z); y[5] = bfhi(o.z); y[6] = bflo(o.w); y[7] = bfhi(o.w);
}
DEVI void ld_f8(const float* src, float (&y)[8]) {
  float4 a = *(const float4*)src, b = *(const float4*)(src + 4);
  y[0] = a.x; y[1] = a.y; y[2] = a.z; y[3] = a.w; y[4] = b.x; y[5] = b.y; y[6] = b.z; y[7] = b.w;
}
DEVI void st_f8(float* dst, const float (&y)[8]) {
  *(float4*)dst = make_float4(y[0], y[1], y[2], y[3]); *(float4*)(dst + 4) = make_float4(y[4], y[5], y[6], y[7]);
}

DEVI void rope8(const float (&x1)[8], const float (&x2)[8], const float4* tab, float sc, float (&y1)[8], float (&y2)[8]) {
#pragma unroll
  for (int e2 = 0; e2 < 4; ++e2) {
    const float4 cs = tab[e2];
    y1[2 * e2] = (x1[2 * e2] * cs.x - x2[2 * e2] * cs.y) * sc;
    y2[2 * e2] = (x2[2 * e2] * cs.x + x1[2 * e2] * cs.y) * sc;
    y1[2 * e2 + 1] = (x1[2 * e2 + 1] * cs.z - x2[2 * e2 + 1] * cs.w) * sc;
    y2[2 * e2 + 1] = (x2[2 * e2 + 1] * cs.z + x1[2 * e2 + 1] * cs.w) * sc;
  }
}

template <int EPI>
DEVI void epi_regs(const Params& p, int mt, int nt, const f32x4 (&acc)[2][2][4][2], int, int, int, int,
                   int mode = 0, u16* dstb = nullptr, int dstride = 0, int dcol = 0) {
  const int tid_ = opaque_tid();
  const int wr = tid_ >> 8, wc = (tid_ >> 6) & 3, fr = tid_ & 15, fq = (tid_ >> 4) & 3;
  char* ws = opaque_ptr(p.ws);
  char* gl = ws + OFF_GL + (size_t)mt * GL_BLOCK;
  const int c0 = wc * 32 + fq * 8;
  float lbv[2][8];
  if (EPI == EPI_F) {
#pragma unroll
    for (int bj = 0; bj < 2; ++bj)
#pragma unroll
      for (int e = 0; e < 8; ++e) lbv[bj][e] = lb_of(p, (nt & 1) * 256 + bj * 128 + c0 + e);
  }
#pragma unroll
  for (int ai = 0; ai < 2; ++ai)
#pragma unroll
    for (int m = 0; m < 4; ++m) {
      const int lr = ai * 128 + wr * 64 + m * 16 + fr;
      const size_t R = (size_t)mt * 256 + lr;
      float va[8], vb[8];
#pragma unroll
      for (int e = 0; e < 4; ++e) { va[e] = acc[ai][0][m][0][e]; va[4 + e] = acc[ai][0][m][1][e]; vb[e] = acc[ai][1][m][0][e]; vb[4 + e] = acc[ai][1][m][1][e]; }
      if (EPI == EPI_AQ) {
        const int hl = c0 >> 5, d0 = c0 & 31;
        const int pos = 16 + (int)(R & 8191);
        const float4* tab = (const float4*)((const float*)(ws + OFF_ROPE) + ((size_t)pos * 32 + d0) * 2);
        float y1[8], y2[8];
        rope8(va, vb, tab, 0.125f, y1, y2);
        u16* dst = (u16*)(ws + OFF_AQ) + R * 512 + (nt & 1) * 256 + hl * 64 + d0;
        st_bf8(dst, y1); st_bf8(dst + 32, y2);
      } else if (EPI == EPI_AKV) {
        if (c0 < 64) {
          const int hl = c0 >> 5, d0 = c0 & 31;
          const int pos = 16 + (int)(R & 8191);
          const float4* tab = (const float4*)((const float*)(ws + OFF_ROPE) + ((size_t)pos * 32 + d0) * 2);
          float y1[8], y2[8];
          rope8(va, vb, tab, 1.0f, y1, y2);
          u16* dst = (u16*)(ws + OFF_AK) + (R + 16) * 128 + hl * 64 + d0;
          st_bf8(dst, y1); st_bf8(dst + 32, y2);
        } else {
          u16* dst = (u16*)(ws + OFF_AV) + (R + 16) * 128 + (c0 - 64);
          st_bf8(dst, va); st_bf8(dst + 64, vb);
        }
      } else if (EPI == EPI_FFI) {
        float y[8];
#pragma unroll
        for (int e = 0; e < 8; ++e) y[e] = silu(va[e]) * vb[e];
        st_bf8((u16*)gl + blk(DFF, 0, lr, nt * 128 + c0), y);
      } else {
#pragma unroll
        for (int bj = 0; bj < 2; ++bj) {
          const int c = bj * 128 + c0;
          float v[8], y[8];
#pragma unroll
          for (int e = 0; e < 8; ++e) v[e] = bj ? vb[e] : va[e];
          if (EPI == EPI_ACT) {
            if (mode == 0) {
#pragma unroll
              for (int e = 0; e < 8; ++e) y[e] = v[e];
            } else {
#pragma unroll
              for (int e = 0; e < 8; ++e) { const float s = sigm(v[e]); y[e] = mode == 1 ? v[e] * s : s; }
            }
            st_bf8(dstb + (size_t)lr * dstride + dcol + c, y);
          } else if (EPI == EPI_F) {
            const int j0 = (nt & 1) * 256 + c;
#pragma unroll
            for (int e = 0; e < 8; ++e) { const float lb = lbv[bj][e]; y[e] = __logf(lb + (1.0f - lb) * sigm(v[e])); }
            st_f8((float*)(gl + GL_LOGF) + lr * 512 + j0, y);
          } else if (EPI == EPI_ATT) {
            const int col = nt * 256 + c;
            float g[8];
            ld_bf8((const u16*)gl + lr * 2048 + 1024 + col, g);
#pragma unroll
            for (int e = 0; e < 8; ++e) y[e] = g[e] * v[e];
            st_f8(p.out + R * 1024 + col, y);
          } else if (EPI == EPI_HG) {
            const int col = nt * 256 + c;
            float g[8], t[8];
            ld_bf8((const u16*)gl + lr * 2048 + col, g);
            ld_f8(p.out + R * 1024 + col, t);
#pragma unroll
            for (int e = 0; e < 8; ++e) y[e] = t[e] + g[e] * v[e];
            st_bf8((u16*)(ws + OFF_R1) + blk(1024, mt, lr, col), y);
          } else if (EPI == EPI_OUT) {
            const int col = nt * 256 + c;
            float xv[8], gm[8], bt[8];
            ld_f8(p.x + R * 1024 + col, xv);
            ld_f8(p.lng + col, gm);
            ld_f8(p.lnb + col, bt);
            const float2 st = *(const float2*)((const float*)(ws + OFF_STATS) + R * 2);
#pragma unroll
            for (int e = 0; e < 8; ++e) y[e] = ALPHA * ((xv[e] - st.x) * st.y * gm[e] + bt[e]) + v[e];
            st_f8(p.out + R * 1024 + col, y);
          } else if (EPI == EPI_FFO) {
            const int col = nt * 256 + c;
            float t[8], gm[8], bt[8];
            ld_f8(p.out + R * 1024 + col, t);
            ld_f8(p.ln1g + col, gm);
            ld_f8(p.ln1b + col, bt);
            const float2 st = *(const float2*)((const float*)(ws + OFF_STATS2) + R * 2);
#pragma unroll
            for (int e = 0; e < 8; ++e) y[e] = ALPHA * ((t[e] - st.x) * st.y * gm[e] + bt[e]) + v[e];
            st_f8(p.out + R * 1024 + col, y);
          }
        }
      }
    }
}


DEVI void ln_rows(const Params& p, int mt, const float* g, const float* b, u16* bfout) {
  const int tid = opaque_tid(), wid = tid >> 6, lane = tid & 63;
#pragma unroll 1
  for (int rr = wid * 4; rr < 256; rr += 32) {
    float4 v[4][4];
#pragma unroll
    for (int q = 0; q < 4; ++q) {
      const float4* row = (const float4*)(p.out + ((size_t)mt * 256 + rr + q) * 1024);
#pragma unroll
      for (int i = 0; i < 4; ++i) v[q][i] = row[i * 64 + lane];
    }
#pragma unroll
    for (int q = 0; q < 4; ++q) {
      const size_t R = (size_t)mt * 256 + rr + q;
      float4* row = (float4*)(p.out + R * 1024);
      float s = 0.f;
#pragma unroll
      for (int i = 0; i < 4; ++i) s += v[q][i].x + v[q][i].y + v[q][i].z + v[q][i].w;
      const float mu = wave_sum(s) * (1.0f / 1024.0f);
      float qq = 0.f;
#pragma unroll
      for (int i = 0; i < 4; ++i) { float a = v[q][i].x - mu, bb = v[q][i].y - mu, c = v[q][i].z - mu, d = v[q][i].w - mu; qq += a * a + bb * bb + c * c + d * d; }
      const float rstd = rsqrtf(wave_sum(qq) * (1.0f / 1024.0f) + EPSF);
      if (bfout && lane == 0) { float* st2 = (float*)(opaque_ptr(p.ws) + OFF_STATS2); st2[R * 2] = mu; st2[R * 2 + 1] = rstd; }
#pragma unroll
      for (int i = 0; i < 4; ++i) {
        float4 g4 = ((const float4*)g)[i * 64 + lane], b4 = ((const float4*)b)[i * 64 + lane];
        float4 y;
        y.x = (v[q][i].x - mu) * rstd * g4.x + b4.x; y.y = (v[q][i].y - mu) * rstd * g4.y + b4.y;
        y.z = (v[q][i].z - mu) * rstd * g4.z + b4.z; y.w = (v[q][i].w - mu) * rstd * g4.w + b4.w;
        if (!bfout) row[i * 64 + lane] = y;
        if (bfout) { uint2 o; o.x = pack2(y.x, y.y); o.y = pack2(y.z, y.w); *(uint2*)(bfout + blk(1024, mt, rr + q, i * 256 + lane * 4)) = o; }
      }
    }
  }
}

DEVI int map_win(int n) {
  if (n < 2048 || n >= 2816) return n;
  if (n < 2560) { const int q = n - 2048, head = q >> 6, d = q & 63; return 2048 + (head >> 2) * 256 + (d >> 5) * 128 + (head & 3) * 32 + (d & 31); }
  if (n < 2688) { const int q = n - 2560, head = q >> 6, d = q & 63; return 2560 + (d >> 5) * 128 + head * 32 + (d & 31); }
  const int q = n - 2688; return 2560 + (q >> 6) * 128 + 64 + (q & 63);
}
DEVI int map_wfi(int n) { return n < DFF ? 256 * (n / 128) + (n % 128) : 256 * ((n - DFF) / 128) + 128 + ((n - DFF) % 128); }

template <int MAP>
DEVI void transpose_tile(const float* __restrict__ src, int K, int N, u16* __restrict__ dst, int k0, int n0, float* tl) {
  const int tid = opaque_tid();
#pragma unroll
  for (int it = 0; it < 8; ++it) { int i = tid + it * NT; int r = i >> 6, c = i & 63; tl[r * 65 + c] = src[(size_t)(k0 + r) * N + n0 + c]; }
  __syncthreads();
#pragma unroll
  for (int it = 0; it < 8; ++it) {
    int i = tid + it * NT; int nn = i >> 6, kk = i & 63;
    const int n = n0 + nn;
    const int dr = MAP == 1 ? map_win(n) : (MAP == 2 ? map_wfi(n) : n);
    dst[blk(K, dr >> 8, dr & 255, k0 + kk)] = f2bf(tl[kk * 65 + nn]);
  }
  __syncthreads();
}

DEVI void phase0(const Params& p, char* smem) {
  const int tid = opaque_tid(), wid = tid >> 6, lane = tid & 63;
  char* ws = opaque_ptr(p.ws);
  {
    float* tl = (float*)smem;
    const bool split_meta = gridDim.x >= 64;
    const int tw = split_meta ? (int)gridDim.x - 20 : (int)gridDim.x;
    for (int t = blockIdx.x; t < 3840 && (int)blockIdx.x < tw; t += tw) {
      if (t < 1216) { int kt = t / 76, ntl = t % 76; transpose_tile<1>(p.w_in, 1024, INW, (u16*)(ws + OFF_WINT), kt * 64, ntl * 64, tl); }
      else if (t < 1344) { int q = t - 1216; int kt = q / 16, ntl = q % 16; transpose_tile<0>(p.w_bhg, 512, 1024, (u16*)(ws + OFF_WBHG), kt * 64, ntl * 64, tl); }
      else if (t < 1472) { int q = t - 1344; int kt = q / 16, ntl = q % 16; transpose_tile<0>(p.w_batt, 512, 1024, (u16*)(ws + OFF_WBATT), kt * 64, ntl * 64, tl); }
      else if (t < 1728) { int q = t - 1472; int kt = q / 16, ntl = q % 16; transpose_tile<0>(p.w_out, 1024, 1024, (u16*)(ws + OFF_WOUT), kt * 64, ntl * 64, tl); }
      else if (t < 3136) { int q = t - 1728; int kt = q / 88, ntl = q % 88; transpose_tile<2>(p.w_fi, 1024, 2 * DFF, (u16*)(ws + OFF_WFI), kt * 64, ntl * 64, tl); }
      else { int q = t - 3136; int kt = q / 16, ntl = q % 16; transpose_tile<0>(p.w_fo, DFF, 1024, (u16*)(ws + OFF_WFO), kt * 64, ntl * 64, tl); }
    }
  }
  {
    u16* h0 = (u16*)((char*)p.out + DOUT_H0);
    float* stats = (float*)(ws + OFF_STATS);
    for (int R0 = (blockIdx.x * 8 + wid) * 2; R0 < ROWS; R0 += gridDim.x * 16) {
      float4 v[2][4];
#pragma unroll
      for (int q = 0; q < 2; ++q) {
        const float4* xr = (const float4*)(p.x + (size_t)(R0 + q) * 1024);
#pragma unroll
        for (int i = 0; i < 4; ++i) v[q][i] = xr[i * 64 + lane];
      }
#pragma unroll
      for (int q = 0; q < 2; ++q) {
        const int R = R0 + q;
        float s = 0.f;
#pragma unroll
        for (int i = 0; i < 4; ++i) s += v[q][i].x + v[q][i].y + v[q][i].z + v[q][i].w;
        const float mu = wave_sum(s) * (1.0f / 1024.0f);
        float qq = 0.f;
#pragma unroll
        for (int i = 0; i < 4; ++i) { float a = v[q][i].x - mu, bb = v[q][i].y - mu, c = v[q][i].z - mu, d = v[q][i].w - mu; qq += a * a + bb * bb + c * c + d * d; }
        const float rstd = rsqrtf(wave_sum(qq) * (1.0f / 1024.0f) + EPSF);
#pragma unroll
        for (int i = 0; i < 4; ++i) {
          float4 g4 = ((const float4*)p.lng)[i * 64 + lane], b4 = ((const float4*)p.lnb)[i * 64 + lane];
          uint2 o;
          o.x = pack2((v[q][i].x - mu) * rstd * g4.x + b4.x, (v[q][i].y - mu) * rstd * g4.y + b4.y);
          o.y = pack2((v[q][i].z - mu) * rstd * g4.z + b4.z, (v[q][i].w - mu) * rstd * g4.w + b4.w);
          *(uint2*)(h0 + blk(1024, R >> 8, R & 255, i * 256 + lane * 4)) = o;
        }
        if (lane == 0) { stats[(size_t)R * 2] = mu; stats[(size_t)R * 2 + 1] = rstd; }
      }
    }
  }
  {
    float2* tab = (float2*)(ws + OFF_ROPE);
    for (int i = blockIdx.x * NT + tid; i < 8208 * 32; i += gridDim.x * NT) {
      float c, s; rope_cs(i >> 5, i & 31, c, s);
      tab[i] = make_float2(c, s);
    }
  }
  {
    float* hm = (float*)smem;
    float* red = (float*)(smem + 65536);
    float* outb = (float*)(smem + 65536 + 32768);
    const bool split_meta = gridDim.x >= 64;
    const int g0 = split_meta ? (int)blockIdx.x - ((int)gridDim.x - 20) : (int)blockIdx.x;
    for (int g = g0; g >= 0 && g < 20; g += (split_meta ? 20 : (int)gridDim.x)) {
      __syncthreads();
      for (int rr = 0; rr < 2; ++rr) {
        const int row = wid * 2 + rr;
        const float4* xr = (const float4*)(p.meta + (size_t)row * 1024);
        float4 v[4];
#pragma unroll
        for (int i = 0; i < 4; ++i) v[i] = xr[i * 64 + lane];
        float s = 0.f;
#pragma unroll
        for (int i = 0; i < 4; ++i) s += v[i].x + v[i].y + v[i].z + v[i].w;
        const float mu = wave_sum(s) * (1.0f / 1024.0f);
        float q = 0.f;
#pragma unroll
        for (int i = 0; i < 4; ++i) { float a = v[i].x - mu, bb = v[i].y - mu, c = v[i].z - mu, d = v[i].w - mu; q += a * a + bb * bb + c * c + d * d; }
        const float rstd = rsqrtf(wave_sum(q) * (1.0f / 1024.0f) + EPSF);
#pragma unroll
        for (int i = 0; i < 4; ++i) {
          float4 g4 = ((const float4*)p.lng)[i * 64 + lane], b4 = ((const float4*)p.lnb)[i * 64 + lane];
          const int k = i * 256 + lane * 4;
          hm[(k + 0) * 16 + row] = (v[i].x - mu) * rstd * g4.x + b4.x;
          hm[(k + 1) * 16 + row] = (v[i].y - mu) * rstd * g4.y + b4.y;
          hm[(k + 2) * 16 + row] = (v[i].z - mu) * rstd * g4.z + b4.z;
          hm[(k + 3) * 16 + row] = (v[i].w - mu) * rstd * g4.w + b4.w;
        }
      }
      __syncthreads();
      const int colbase = g < 8 ? 512 + g * 64 : g < 16 ? 1024 + (g - 8) * 64 : g < 18 ? 2560 + (g - 16) * 64 : 2688 + (g - 18) * 64;
      const int col = colbase + lane;
      float a0 = 0, a1 = 0, a2 = 0, a3 = 0, a4 = 0, a5 = 0, a6 = 0, a7 = 0, a8 = 0, a9 = 0, a10 = 0, a11 = 0, a12 = 0, a13 = 0, a14 = 0, a15 = 0;
#pragma unroll 4
      for (int k = wid * 128; k < wid * 128 + 128; ++k) {
        const float wv = p.w_in[(size_t)k * INW + col];
        const float4* h4 = (const float4*)(hm + k * 16);
        const float4 A = h4[0], B = h4[1], C = h4[2], D = h4[3];
        a0 += A.x * wv; a1 += A.y * wv; a2 += A.z * wv; a3 += A.w * wv;
        a4 += B.x * wv; a5 += B.y * wv; a6 += B.z * wv; a7 += B.w * wv;
        a8 += C.x * wv; a9 += C.y * wv; a10 += C.z * wv; a11 += C.w * wv;
        a12 += D.x * wv; a13 += D.y * wv; a14 += D.z * wv; a15 += D.w * wv;
      }
      float* rw = red + (wid * 16) * 64 + lane;
      rw[0 * 64] = a0; rw[1 * 64] = a1; rw[2 * 64] = a2; rw[3 * 64] = a3; rw[4 * 64] = a4; rw[5 * 64] = a5; rw[6 * 64] = a6; rw[7 * 64] = a7;
      rw[8 * 64] = a8; rw[9 * 64] = a9; rw[10 * 64] = a10; rw[11 * 64] = a11; rw[12 * 64] = a12; rw[13 * 64] = a13; rw[14 * 64] = a14; rw[15 * 64] = a15;
      __syncthreads();
      for (int i = tid; i < 1024; i += NT) {
        const int r = i >> 6, l = i & 63;
        float s = 0.f;
#pragma unroll
        for (int w = 0; w < 8; ++w) s += red[(w * 16 + r) * 64 + l];
        outb[r * 64 + l] = s;
      }
      __syncthreads();
      for (int i = tid; i < 1024; i += NT) {
        const int r = i >> 6, l = i & 63;
        const float val = outb[r * 64 + l];
        if (g < 8) {
          const int j = g * 64 + l; const float lb = lb_of(p, j);
          ((float*)(ws + OFF_MLOGF))[r * 512 + j] = __logf(lb + (1.0f - lb) * sigm(val));
        } else if (g < 16) {
          ((float*)(ws + OFF_MV))[r * 512 + (g - 8) * 64 + l] = val;
        } else if (g < 18) {
          float c, s; rope_cs(r, l & 31, c, s);
          const float other = outb[r * 64 + (l ^ 32)];
          const float y = (l < 32) ? val * c - other * s : val * c + other * s;
          ((u16*)(ws + OFF_AK))[r * 128 + (g - 16) * 64 + l] = f2bf(y);
        } else {
          ((u16*)(ws + OFF_AV))[r * 128 + (g - 18) * 64 + l] = f2bf(val);
        }
      }
      __syncthreads();
    }
  }
}

constexpr int HST = 136;

DEVI void load_vt(const u16* __restrict__ hv, size_t R0, int h, u16* Vt) {
  const int tid = opaque_tid();
  const int d = tid & 127, seg = tid >> 7;
  unsigned vv[32];
#pragma unroll
  for (int i = 0; i < 32; ++i) vv[i] = hv[(R0 + seg * 32 + i) * 512 + h * 128 + d];
#pragma unroll
  for (int i = 0; i < 32; i += 2) *(unsigned*)(Vt + d * HST + seg * 32 + i) = vv[i] | (vv[i + 1] << 16);
}

DEVI void hgrn_local(const Params& p, int mt, char* smem) {
  const int tid = opaque_tid(), wid = tid >> 6, lane = tid & 63, fr = lane & 15, fq = lane >> 4;
  char* ws = opaque_ptr(p.ws);
  u16* At = (u16*)smem;
  u16* Vt = (u16*)(smem + 128 * HST * 2);
  float* tot = (float*)(smem + 2 * 128 * HST * 2);
  const float* logf = (const float*)(ws + OFF_GL + (size_t)mt * GL_BLOCK + GL_LOGF);
  const u16* hv = (const u16*)(ws + OFF_HV);
  float* U = p.out;
  float* dvec = (float*)(ws + OFF_DVEC);
#pragma unroll 1
  for (int un = 0; un < 8; ++un) {
    const int cl = un >> 2, h = un & 3;
    const size_t R0 = (size_t)mt * 256 + cl * 128;
    const int u = (mt * 2 + cl) * 4 + h;
    const int k = tid & 127, seg = tid >> 7;
    const float* lfp = logf + (cl * 128 + seg * 32) * 512 + h * 128 + k;
    float lf[32];
#pragma unroll
    for (int i = 0; i < 32; ++i) lf[i] = lfp[i * 512];
    load_vt(hv, R0, h, Vt);
    float T = 0.f;
#pragma unroll
    for (int i = 0; i < 32; ++i) T += lf[i];
    tot[seg * 128 + k] = T;
    __syncthreads();
    float run = 0.f;
#pragma unroll
    for (int s2 = 3; s2 >= 1; --s2) if (s2 > seg) run += tot[s2 * 128 + k];
#pragma unroll
    for (int i = 31; i >= 1; i -= 2) {
      const float l1 = lf[i], l0 = lf[i - 1];
      const float a1 = (1.0f - __expf(l1)) * __expf(run);
      run += l1;
      const float a0 = (1.0f - __expf(l0)) * __expf(run);
      run += l0;
      *(unsigned*)(At + k * HST + seg * 32 + i - 1) = pack2(a0, a1);
    }
    if (seg == 0) dvec[(size_t)u * 128 + k] = __expf(run);
    __syncthreads();
    f32x4 acc[8];
#pragma unroll
    for (int j = 0; j < 8; ++j) acc[j] = f32x4{0.f, 0.f, 0.f, 0.f};
#pragma unroll
    for (int ks = 0; ks < 4; ++ks) {
      const bf16x8 a = *(const bf16x8*)(Vt + (wid * 16 + fr) * HST + ks * 32 + fq * 8);
#pragma unroll
      for (int j = 0; j < 8; ++j) {
        const bf16x8 b = *(const bf16x8*)(At + (j * 16 + fr) * HST + ks * 32 + fq * 8);
        acc[j] = __builtin_amdgcn_mfma_f32_16x16x32_bf16(a, b, acc[j], 0, 0, 0);
      }
    }
    float* Uu = U + (size_t)u * 16384;
#pragma unroll
    for (int j = 0; j < 8; ++j)
#pragma unroll
      for (int r = 0; r < 4; ++r) Uu[(wid * 16 + fq * 4 + r) * 128 + j * 16 + fr] = acc[j][r];
    __syncthreads();
  }
}

DEVI void hgrn_scan(const Params& p) {
  char* ws = opaque_ptr(p.ws);
  const float* mlogf = (const float*)(ws + OFF_MLOGF);
  const float* mv = (const float*)(ws + OFF_MV);
  const float* U = p.out;
  const float* dvec = (const float*)(ws + OFF_DVEC);
  for (int idx = blockIdx.x * NT + opaque_tid(); idx < 131072; idx += gridDim.x * NT) {
    const int k4 = idx & 31, v = (idx >> 5) & 127, bh = idx >> 12, b = bh >> 2, h = bh & 3;
    float S[4] = {0.f, 0.f, 0.f, 0.f};
    float run[4] = {0.f, 0.f, 0.f, 0.f};
#pragma unroll
    for (int j = 15; j >= 0; --j) {
      const float4 lf = *(const float4*)(mlogf + j * 512 + h * 128 + k4 * 4);
      const float vv = mv[j * 512 + h * 128 + v];
      S[0] += (1.0f - __expf(lf.x)) * __expf(run[0]) * vv; run[0] += lf.x;
      S[1] += (1.0f - __expf(lf.y)) * __expf(run[1]) * vv; run[1] += lf.y;
      S[2] += (1.0f - __expf(lf.z)) * __expf(run[2]) * vv; run[2] += lf.z;
      S[3] += (1.0f - __expf(lf.w)) * __expf(run[3]) * vv; run[3] += lf.w;
    }
#pragma unroll 8
    for (int c = 0; c < 64; ++c) {
      const int gc = b * 64 + c;
      const int u = gc * 4 + h;
      const int mt = gc >> 1, cl = gc & 1;
      u16* dst = (u16*)(ws + OFF_R1 + (size_t)mt * 524288) + ((cl * 4 + h) * 16384 + v * 128 + k4 * 4);
      uint2 o; o.x = pack2(S[0], S[1]); o.y = pack2(S[2], S[3]);
      *(uint2*)dst = o;
      const float4 uu = *(const float4*)(U + (size_t)u * 16384 + v * 128 + k4 * 4);
      const float4 dd = *(const float4*)(dvec + (size_t)u * 128 + k4 * 4);
      S[0] = dd.x * S[0] + uu.x; S[1] = dd.y * S[1] + uu.y; S[2] = dd.z * S[2] + uu.z; S[3] = dd.w * S[3] + uu.w;
    }
  }
}

DEVI void hgrn_out(const Params& p, int mt, char* smem) {
  const int tid = opaque_tid(), wid = tid >> 6, lane = tid & 63, fr = lane & 15, fq = lane >> 4;
  char* ws = opaque_ptr(p.ws);
  u16* Qb = (u16*)smem;
  u16* Q1 = Qb + 128 * HST;
  u16* K0 = Q1 + 64 * HST;
  u16* K1 = K0 + 64 * HST;
  u16* Vt = K1 + 128 * HST;
  float* tot = (float*)(Vt + 128 * HST);
  const float* logf = (const float*)(ws + OFF_GL + (size_t)mt * GL_BLOCK + GL_LOGF);
  const u16* hq = (const u16*)(ws + OFF_HQ);
  const u16* hv = (const u16*)(ws + OFF_HV);
  const u16* hg = (const u16*)(ws + OFF_HG);
  u16* ho = (u16*)(ws + OFF_HO);
#pragma unroll 1
  for (int un = 0; un < 8; ++un) {
    const int cl = un >> 2, h = un & 3;
    const size_t R0 = (size_t)mt * 256 + cl * 128;
    const u16* St = (const u16*)(ws + OFF_R1 + (size_t)mt * 524288) + (cl * 4 + h) * 16384;
    bf16x8 sb[2][8];
    {
      const int k = tid & 127, seg = tid >> 7;
      const float* lfp = logf + (cl * 128 + seg * 32) * 512 + h * 128 + k;
      const u16* qp_ = hq + (R0 + seg * 32) * 512 + h * 128 + k;
      float lf[32]; unsigned qr[32];
#pragma unroll
      for (int i = 0; i < 32; ++i) { lf[i] = lfp[i * 512]; qr[i] = qp_[i * 512]; }
#pragma unroll
      for (int ks = 0; ks < 2; ++ks)
#pragma unroll
        for (int j = 0; j < 8; ++j) sb[ks][j] = *(const bf16x8*)(St + (j * 16 + fr) * 128 + ks * 32 + fq * 8);
      load_vt(hv, R0, h, Vt);
      float T = 0.f;
#pragma unroll
      for (int i = 0; i < 32; ++i) T += lf[i];
      tot[seg * 128 + k] = T;
      __syncthreads();
      float run = 0.f;
#pragma unroll
      for (int s2 = 0; s2 < 3; ++s2) if (s2 < seg) run += tot[s2 * 128 + k];
      const float r1 = tot[k] + tot[128 + k];
      const bool hi = seg >= 2;
      u16* xdst = hi ? (Q1 + (seg * 32 - 64) * HST + k) : (K0 + (seg * 32) * HST + k);
#pragma unroll
      for (int i = 0; i < 32; ++i) {
        const int t = seg * 32 + i;
        const float l = lf[i];
        run += l;
        const float qv = __uint_as_float(qr[i] << 16);
        const float kk = 1.0f - __expf(l);
        Qb[t * HST + k] = f2bf(qv * __expf(run));
        K1[t * HST + k] = f2bf(kk * __expf(r1 - run));
        xdst[i * HST] = f2bf((hi ? qv : kk) * __expf(hi ? (run - r1) : -run));
      }
    }
    __syncthreads();
    f32x4 acc[8];
#pragma unroll
    for (int j = 0; j < 8; ++j) acc[j] = f32x4{0.f, 0.f, 0.f, 0.f};
    {
      bf16x8 sc[2][8];
#pragma unroll
      for (int ks = 0; ks < 2; ++ks)
#pragma unroll
        for (int j = 0; j < 8; ++j) sc[ks][j] = *(const bf16x8*)(St + (j * 16 + fr) * 128 + (ks + 2) * 32 + fq * 8);
#pragma unroll
      for (int ks = 0; ks < 2; ++ks) {
        const bf16x8 a = *(const bf16x8*)(Qb + (wid * 16 + fr) * HST + ks * 32 + fq * 8);
#pragma unroll
        for (int j = 0; j < 8; ++j) acc[j] = __builtin_amdgcn_mfma_f32_16x16x32_bf16(a, sb[ks][j], acc[j], 0, 0, 0);
      }
#pragma unroll
      for (int ks = 0; ks < 2; ++ks) {
        const bf16x8 a = *(const bf16x8*)(Qb + (wid * 16 + fr) * HST + (ks + 2) * 32 + fq * 8);
#pragma unroll
        for (int j = 0; j < 8; ++j) acc[j] = __builtin_amdgcn_mfma_f32_16x16x32_bf16(a, sc[ks][j], acc[j], 0, 0, 0);
      }
    }
    {
      const int H = wid >> 2;
      const u16* Qsrc = H ? (Q1 + ((wid - 4) * 16 + fr) * HST) : (Qb + (wid * 16 + fr) * HST);
      const u16* Ksrc = H ? K1 : K0;
      bf16x8 qf[4];
      bf16x4 vlo[8], vhi[8];
#pragma unroll
      for (int ks = 0; ks < 4; ++ks) qf[ks] = *(const bf16x8*)(Qsrc + ks * 32 + fq * 8);
#pragma unroll
      for (int g = 0; g < 4; ++g) {
        if (2 * g <= wid) {
          f32x4 s0 = f32x4{0.f, 0.f, 0.f, 0.f}, s1 = f32x4{0.f, 0.f, 0.f, 0.f};
          {
            bf16x8 ka[4], kb[4];
            const bool two = (2 * g + 1 <= wid);
#pragma unroll
            for (int ks = 0; ks < 4; ++ks) {
              ka[ks] = *(const bf16x8*)(Ksrc + ((2 * g) * 16 + fr) * HST + ks * 32 + fq * 8);
              kb[ks] = *(const bf16x8*)(Ksrc + ((two ? 2 * g + 1 : 2 * g) * 16 + fr) * HST + ks * 32 + fq * 8);
            }
#pragma unroll
            for (int j = 0; j < 8; ++j) {
              const u16* vp = Vt + (j * 16 + fr) * HST + g * 32 + fq * 4;
              vlo[j] = *(const bf16x4*)vp; vhi[j] = *(const bf16x4*)(vp + 16);
            }
#pragma unroll
            for (int ks = 0; ks < 4; ++ks) s0 = __builtin_amdgcn_mfma_f32_16x16x32_bf16(ka[ks], qf[ks], s0, 0, 0, 0);
#pragma unroll
            for (int ks = 0; ks < 4; ++ks) s1 = __builtin_amdgcn_mfma_f32_16x16x32_bf16(kb[ks], qf[ks], s1, 0, 0, 0);
            if (!two) s1 = f32x4{0.f, 0.f, 0.f, 0.f};
          }
          if (2 * g == wid) {
#pragma unroll
            for (int r = 0; r < 4; ++r) if (fq * 4 + r > fr) s0[r] = 0.f;
          }
          if (2 * g + 1 == wid) {
#pragma unroll
            for (int r = 0; r < 4; ++r) if (fq * 4 + r > fr) s1[r] = 0.f;
          }
          bf16x8 pf;
          pf[0] = (short)f2bf(s0[0]); pf[1] = (short)f2bf(s0[1]); pf[2] = (short)f2bf(s0[2]); pf[3] = (short)f2bf(s0[3]);
          pf[4] = (short)f2bf(s1[0]); pf[5] = (short)f2bf(s1[1]); pf[6] = (short)f2bf(s1[2]); pf[7] = (short)f2bf(s1[3]);
#pragma unroll
          for (int j = 0; j < 8; ++j) {
            bf16x8 b;
            b[0] = vlo[j][0]; b[1] = vlo[j][1]; b[2] = vlo[j][2]; b[3] = vlo[j][3]; b[4] = vhi[j][0]; b[5] = vhi[j][1]; b[6] = vhi[j][2]; b[7] = vhi[j][3];
            acc[j] = __builtin_amdgcn_mfma_f32_16x16x32_bf16(pf, b, acc[j], 0, 0, 0);
          }
        }
      }
    }
    __syncthreads();
    {
      float ss[4];
#pragma unroll
      for (int r = 0; r < 4; ++r) {
        float s = 0.f;
#pragma unroll
        for (int j = 0; j < 8; ++j) s += acc[j][r] * acc[j][r];
        s += __shfl_xor(s, 1); s += __shfl_xor(s, 2); s += __shfl_xor(s, 4); s += __shfl_xor(s, 8);
        ss[r] = rsqrtf(s * (1.0f / 128.0f) + EPSF);
      }
#pragma unroll
      for (int j = 0; j < 8; ++j) {
        const float ng = p.hgng[j * 16 + fr];
#pragma unroll
        for (int r = 0; r < 4; ++r) {
          const size_t off = (R0 + wid * 16 + fq * 4 + r) * 512 + h * 128 + j * 16 + fr;
          ho[blk(512, mt, cl * 128 + wid * 16 + fq * 4 + r, h * 128 + j * 16 + fr)] = f2bf(acc[j][r] * ss[r] * ng * bf2f(hg[off]));
        }
      }
    }
    __syncthreads();
  }
}

constexpr int KST = 72;
constexpr int VST = 296;
DEVI void attention(const Params& p, int mt, char* smem) {
  const int tid = opaque_tid(), wid = tid >> 6, lane = tid & 63, fr = lane & 15, fq = lane >> 4;
  char* ws = opaque_ptr(p.ws);
  u16* Ks = (u16*)smem;
  u16* Vt = (u16*)(smem + 272 * KST * 2);
  const u16* aq = (const u16*)(ws + OFF_AQ);
  const u16* ak = (const u16*)(ws + OFF_AK);
  const u16* av = (const u16*)(ws + OFF_AV);
  u16* ao = (u16*)(ws + OFF_AO);
#pragma unroll 1
  for (int un = 0; un < 4; ++un) {
    const int cl = un >> 1, kvh = un & 1;
    const size_t R0 = (size_t)mt * 256 + cl * 128;
    const bool has_prev = (R0 & 8191) != 0;
    auto krow_of = [&](int kk) -> size_t {
      if (kk < 16) return (size_t)kk;
      if (kk < 144) return has_prev ? (16 + R0 - 128 + (kk - 16)) : (16 + R0 + (kk - 16));
      return 16 + R0 + (kk - 144);
    };
#pragma unroll
    for (int it = 0; it < 5; ++it) {
      const int i = it * NT + tid;
      if (i >= 272 * 8) break;
      const int kk = i >> 3, ch = i & 7;
      const uint4 kv = *(const uint4*)(ak + krow_of(kk) * 128 + kvh * 64 + ch * 8);
      *(uint4*)(Ks + kk * KST + ch * 8) = kv;
    }
#pragma unroll
    for (int it = 0; it < 3; ++it) {
      const int i = it * NT + tid;
      if (i >= 136 * 8) break;
      const int kp = i % 136, ch = i / 136;
      const uint4 v0 = *(const uint4*)(av + krow_of(2 * kp) * 128 + kvh * 64 + ch * 8);
      const uint4 v1 = *(const uint4*)(av + krow_of(2 * kp + 1) * 128 + kvh * 64 + ch * 8);
      unsigned* vd = (unsigned*)(Vt + (ch * 8) * VST + 2 * kp);
      constexpr int VS2 = VST / 2;
      vd[0 * VS2] = (v0.x & 0xffffu) | (v1.x << 16); vd[1 * VS2] = (v0.x >> 16) | (v1.x & 0xffff0000u);
      vd[2 * VS2] = (v0.y & 0xffffu) | (v1.y << 16); vd[3 * VS2] = (v0.y >> 16) | (v1.y & 0xffff0000u);
      vd[4 * VS2] = (v0.z & 0xffffu) | (v1.z << 16); vd[5 * VS2] = (v0.z >> 16) | (v1.z & 0xffff0000u);
      vd[6 * VS2] = (v0.w & 0xffffu) | (v1.w << 16); vd[7 * VS2] = (v0.w >> 16) | (v1.w & 0xffff0000u);
    }
    __syncthreads();
    const int qt = wid;
    const int iq = qt * 16 + fr;
    const int lo = has_prev ? (iq + 1) : max(iq + 1, 128);
    const unsigned hi_lo = (unsigned)(iq + 128 - lo);
#pragma unroll 1
    for (int g = 0; g < 4; ++g) {
      asm volatile("" ::: "memory");
      const int hq = kvh * 4 + g;
      const float sink = p.sinks[hq];
      const u16* qp = aq + (R0 + qt * 16 + fr) * 512 + hq * 64 + fq * 8;
      const bf16x8 qf0 = *(const bf16x8*)qp;
      const bf16x8 qf1 = *(const bf16x8*)(qp + 32);
      f32x4 sT[10];
#pragma unroll
      for (int ih = 0; ih < 2; ++ih) {
        bf16x8 k0[5], k1[5];
#pragma unroll
        for (int ii = 0; ii < 5; ++ii) {
          const int i = ih * 5 + ii;
          const int krow = (i < 9) ? (16 + (qt + i) * 16) : 0;
          const u16* kp = Ks + (krow + fr) * KST + fq * 8;
          k0[ii] = *(const bf16x8*)kp; k1[ii] = *(const bf16x8*)(kp + 32);
        }
#pragma unroll
        for (int ii = 0; ii < 5; ++ii) {
          f32x4 s = f32x4{0.f, 0.f, 0.f, 0.f};
          s = __builtin_amdgcn_mfma_f32_16x16x32_bf16(k0[ii], qf0, s, 0, 0, 0);
          s = __builtin_amdgcn_mfma_f32_16x16x32_bf16(k1[ii], qf1, s, 0, 0, 0);
          sT[ih * 5 + ii] = s;
        }
      }
      float m = sink;
#pragma unroll
      for (int i = 0; i < 9; ++i)
#pragma unroll
        for (int r = 0; r < 4; ++r) {
          if (i == 0 || i == 8 || !has_prev) {
            const int jb = (qt + i) * 16 + fq * 4 + r;
            const bool ok = (unsigned)(jb - lo) <= hi_lo;
            sT[i][r] = ok ? sT[i][r] : -3.0e38f;
          }
          m = fmaxf(m, sT[i][r]);
        }
#pragma unroll
      for (int r = 0; r < 4; ++r) m = fmaxf(m, sT[9][r]);
      m = fmaxf(m, __shfl_xor(m, 16)); m = fmaxf(m, __shfl_xor(m, 32));
      float l = 0.f;
#pragma unroll
      for (int i = 0; i < 10; ++i)
#pragma unroll
        for (int r = 0; r < 4; ++r) {
          const float e = __expf(sT[i][r] - m);
          sT[i][r] = e; l += e;
        }
      l += __shfl_xor(l, 16); l += __shfl_xor(l, 32);
      l += __expf(sink - m);
      const float linv = 1.0f / l;
      f32x4 o[4];
#pragma unroll
      for (int dt = 0; dt < 4; ++dt) o[dt] = f32x4{0.f, 0.f, 0.f, 0.f};
#pragma unroll
      for (int gp = 0; gp < 5; ++gp) {
        const int ia = 2 * gp, ib = 2 * gp + 1;
        const int krowa = 16 + (qt + ia) * 16;
        const int krowb = (ib < 9) ? (16 + (qt + ib) * 16) : 0;
        bf16x8 pf;
        pf[0] = (short)f2bf(sT[ia][0]); pf[1] = (short)f2bf(sT[ia][1]); pf[2] = (short)f2bf(sT[ia][2]); pf[3] = (short)f2bf(sT[ia][3]);
        pf[4] = (short)f2bf(sT[ib][0]); pf[5] = (short)f2bf(sT[ib][1]); pf[6] = (short)f2bf(sT[ib][2]); pf[7] = (short)f2bf(sT[ib][3]);
        bf16x4 v0[4], v1[4];
#pragma unroll
        for (int dt = 0; dt < 4; ++dt) {
          const u16* vp = Vt + (dt * 16 + fr) * VST + fq * 4;
          v0[dt] = *(const bf16x4*)(vp + krowa); v1[dt] = *(const bf16x4*)(vp + krowb);
        }
#pragma unroll
        for (int dt = 0; dt < 4; ++dt) {
          bf16x8 b;
          b[0] = v0[dt][0]; b[1] = v0[dt][1]; b[2] = v0[dt][2]; b[3] = v0[dt][3]; b[4] = v1[dt][0]; b[5] = v1[dt][1]; b[6] = v1[dt][2]; b[7] = v1[dt][3];
          o[dt] = __builtin_amdgcn_mfma_f32_16x16x32_bf16(pf, b, o[dt], 0, 0, 0);
        }
      }
#pragma unroll
      for (int r = 0; r < 4; ++r) {
        const float li = __shfl(linv, fq * 4 + r);
#pragma unroll
        for (int dt = 0; dt < 4; ++dt)
          ao[blk(512, mt, cl * 128 + qt * 16 + fq * 4 + r, hq * 64 + dt * 16 + fr)] = f2bf(o[dt][r] * li);
      }
    }
    __syncthreads();
  }
}

DEVI bool unit_of(int i, int nN, int& pm, int& pn) {
  const int nwg = NTILE * nN;
  const int L = i * (int)gridDim.x + (int)blockIdx.x;
  if (L >= nwg) return false;
  const int q = nwg >> 3;
  const int wgid = (L & 7) * q + (L >> 3);
  const int nig = 8 * nN, gid = wgid / nig, rem = wgid - gid * nig;
  pm = gid * 8 + (rem & 7); pn = rem >> 3;
  return true;
}
DEVI int units_of(int nN) { const int nwg = NTILE * nN; const int c = blockIdx.x, G = gridDim.x; return c < nwg ? (nwg - c + G - 1) / G : 0; }

__global__ void __launch_bounds__(NT, 2) fwd_megakernel(Params p) {
  extern __shared__ __attribute__((aligned(16))) char smem[];
  cg::grid_group grid = cg::this_grid();
  for (int ph = p.ph_lo; ph < p.ph_hi; ++ph) {
    if (ph > p.ph_lo) grid.sync();
    char* ws = opaque_ptr(p.ws);
    if (ph == 0) {
      for (int r_ = 0; r_ < PROBE_A; ++r_) { phase0(p, smem); __syncthreads(); }
    } else if (ph == 1) {
      for (int rep_ = 0; rep_ < PROBE_P1; ++rep_) {
      const char* h0b = (const char*)p.out + DOUT_H0;
      const char* wint = ws + OFF_WINT;
      gemm_stream<1024>(units_of(19),
        [&](int i, const char*& A, const char*& B) { int pm, pn; unit_of(i, 19, pm, pn); A = h0b + (size_t)pm * 256 * 1024 * 2; B = wint + (size_t)pn * 256 * 1024 * 2; },
        [&](int i, const f32x4 (&acc)[2][2][4][2], int wr, int wc, int fr, int fq) {
          int mt, nt; unit_of(i, 19, mt, nt);
          char* w2 = opaque_ptr(p.ws);
          if (nt == 2 || nt == 3) epi_regs<EPI_F>(p, mt, nt, acc, wr, wc, fr, fq);
          else if (nt == 8 || nt == 9) epi_regs<EPI_AQ>(p, mt, nt, acc, wr, wc, fr, fq);
          else if (nt == 10) epi_regs<EPI_AKV>(p, mt, nt, acc, wr, wc, fr, fq);
          else {
            int mode, dstride, dcol; u16* dstb;
            if (nt < 2) { mode = 1; dstb = (u16*)(w2 + OFF_HQ) + (size_t)mt * 256 * 512; dstride = 512; dcol = nt * 256; }
            else if (nt < 6) { mode = 0; dstb = (u16*)(w2 + OFF_HV) + (size_t)mt * 256 * 512; dstride = 512; dcol = (nt - 4) * 256; }
            else if (nt < 8) { mode = 1; dstb = (u16*)(w2 + OFF_HG) + (size_t)mt * 256 * 512; dstride = 512; dcol = (nt - 6) * 256; }
            else { mode = 2; dstb = (u16*)(w2 + OFF_GL + (size_t)mt * GL_BLOCK); dstride = 2048; dcol = (nt - 11) * 256; }
            epi_regs<EPI_ACT>(p, mt, nt, acc, wr, wc, fr, fq, mode, dstb, dstride, dcol);
          }
        }, smem);
      __syncthreads();
      }
    } else if (ph == 2) {
      for (int r_ = 0; r_ < PROBE_B; ++r_)
      for (int mt = blockIdx.x; mt < NTILE; mt += gridDim.x) {
        __syncthreads();
        attention(p, mt, smem);
        hgrn_local(p, mt, smem);
      }
    } else if (ph == 3) {
      for (int r_ = 0; r_ < PROBE_C; ++r_) hgrn_scan(p);
    } else if (ph == 4) {
      for (int mt = blockIdx.x; mt < NTILE; mt += gridDim.x) {
        __syncthreads();
        for (int r_ = 0; r_ < PROBE_D; ++r_) hgrn_out(p, mt, smem);
        __syncthreads();
        {
          const char* ao = ws + OFF_AO + (size_t)mt * 256 * 512 * 2; const char* ho = ws + OFF_HO + (size_t)mt * 256 * 512 * 2;
          const char* wa = ws + OFF_WBATT; const char* wh = ws + OFF_WBHG;
          gemm_stream<512>(8,
            [&](int i, const char*& A, const char*& B) { A = (i & 1) ? ho : ao; B = ((i & 1) ? wh : wa) + (size_t)(i >> 1) * 256 * 512 * 2; },
            [&](int i, const f32x4 (&acc)[2][2][4][2], int wr, int wc, int fr, int fq) {
              if (i & 1) epi_regs<EPI_HG>(p, mt, i >> 1, acc, wr, wc, fr, fq); else epi_regs<EPI_ATT>(p, mt, i >> 1, acc, wr, wc, fr, fq);
            }, smem);
        }
        __syncthreads();
        const char* r1 = ws + OFF_R1 + (size_t)mt * 256 * 1024 * 2;
        {
          const char* wo = ws + OFF_WOUT;
          gemm_stream<1024>(4,
            [&](int i, const char*& A, const char*& B) { A = r1; B = wo + (size_t)i * 256 * 1024 * 2; },
            [&](int i, const f32x4 (&acc)[2][2][4][2], int wr, int wc, int fr, int fq) { epi_regs<EPI_OUT>(p, mt, i, acc, wr, wc, fr, fq); }, smem);
        }
        __syncthreads();
        ln_rows(p, mt, p.ln1g, p.ln1b, (u16*)(ws + OFF_R1));
        __syncthreads();
        {
          const char* wf = ws + OFF_WFI;
          gemm_stream<1024>(22,
            [&](int i, const char*& A, const char*& B) { A = r1; B = wf + (size_t)i * 256 * 1024 * 2; },
            [&](int i, const f32x4 (&acc)[2][2][4][2], int wr, int wc, int fr, int fq) { epi_regs<EPI_FFI>(p, mt, i, acc, wr, wc, fr, fq); }, smem);
        }
        __syncthreads();
        {
          const char* glb = ws + OFF_GL + (size_t)mt * GL_BLOCK; const char* wf = ws + OFF_WFO;
          gemm_stream<DFF>(4,
            [&](int i, const char*& A, const char*& B) { A = glb; B = wf + (size_t)i * 256 * DFF * 2; },
            [&](int i, const f32x4 (&acc)[2][2][4][2], int wr, int wc, int fr, int fq) { epi_regs<EPI_FFO>(p, mt, i, acc, wr, wc, fr, fq); }, smem);
        }
        __syncthreads();
        ln_rows(p, mt, p.ln2g, p.ln2b, nullptr);
      }
    }
  }
}

extern "C" void kernel_launch(void* const* d_in, const int* in_sizes, int n_in, void* d_out, int out_size, void* d_ws, size_t ws_size,
                              hipStream_t stream) {
  static int grid_blocks = 0;
  if (!grid_blocks) {
    if (ws_size < WS_END) { fprintf(stderr, "kernel_launch: workspace too small: %zu < %zu\n", ws_size, (size_t)WS_END); grid_blocks = -1; return; }
    int dev = 0, cus = 0, per_cu = 0;
    hipGetDevice(&dev);
    hipDeviceGetAttribute(&cus, hipDeviceAttributeMultiprocessorCount, dev);
    if (hipFuncSetAttribute((const void*)fwd_megakernel, hipFuncAttributeMaxDynamicSharedMemorySize, LDS_BYTES) != hipSuccess)
      fprintf(stderr, "kernel_launch: hipFuncSetAttribute failed\n");
    hipOccupancyMaxActiveBlocksPerMultiprocessor(&per_cu, (const void*)fwd_megakernel, NT, LDS_BYTES);
    if (per_cu < 1) { fprintf(stderr, "kernel_launch: occupancy query says %d blocks/CU\n", per_cu); per_cu = 1; }
    int g = cus * per_cu;
    if (g > NTILE) g = NTILE;
    grid_blocks = g;
  }
  if (grid_blocks < 0) return;
  Params p{};
  p.x = (const float*)d_in[0]; p.meta = (const float*)d_in[1]; p.lng = (const float*)d_in[2]; p.lnb = (const float*)d_in[3];
  p.w_in = (const float*)d_in[4]; p.hglb = (const float*)d_in[5]; p.hgng = (const float*)d_in[6]; p.sinks = (const float*)d_in[7];
  p.w_bhg = (const float*)d_in[8]; p.w_batt = (const float*)d_in[9]; p.w_out = (const float*)d_in[10];
  p.ln1g = (const float*)d_in[11]; p.ln1b = (const float*)d_in[12]; p.w_fi = (const float*)d_in[13]; p.w_fo = (const float*)d_in[14];
  p.ln2g = (const float*)d_in[15]; p.ln2b = (const float*)d_in[16];
  p.out = (float*)d_out; p.ws = (char*)d_ws;
  constexpr int NPHASE = 5;
  int cuts[MK_LAUNCHES + 1];
  for (int li = 0; li <= MK_LAUNCHES; ++li) cuts[li] = (MK_LAUNCHES == 1) ? (li ? NPHASE : 0) : li;
  for (int li = 0; li < MK_LAUNCHES; ++li) {
    p.ph_lo = cuts[li]; p.ph_hi = cuts[li + 1];
    void* args[] = {&p};
    hipError_t e = hipLaunchCooperativeKernel((const void*)fwd_megakernel, dim3(grid_blocks), dim3(NT), args, LDS_BYTES, stream);
    if (e != hipSuccess) { fprintf(stderr, "cooperative launch %d failed: %s (grid %d)\n", li, hipGetErrorString(e), grid_blocks); break; }
  }
}
```

```cpp
#include <hip/hip_runtime.h>
#include <hip/hip_cooperative_groups.h>
#include <cstdio>
namespace cg = cooperative_groups;

#ifndef MK_LAUNCHES
#define MK_LAUNCHES 1
#endif

#define DEVI __device__ __forceinline__
typedef unsigned short u16;
using bf16x8 = __attribute__((ext_vector_type(8))) short;
using bf16x4 = __attribute__((ext_vector_type(4))) short;
using f32x4 = __attribute__((ext_vector_type(4))) float;

constexpr int NT = 512;
constexpr int ROWS = 65536;
constexpr int NTILE = 256;
constexpr int INW = 4864;
constexpr int DFF = 2816;
constexpr float EPSF = 1e-5f;
constexpr float ALPHA = 1.189207115002721f;

constexpr size_t OFF_WINT  = 0;
constexpr size_t OFF_WBHG  = OFF_WINT  + (size_t)INW * 1024 * 2;
constexpr size_t OFF_WBATT = OFF_WBHG  + (size_t)1024 * 512 * 2;
constexpr size_t OFF_WOUT  = OFF_WBATT + (size_t)1024 * 512 * 2;
constexpr size_t OFF_WFI   = OFF_WOUT  + (size_t)1024 * 1024 * 2;
constexpr size_t OFF_WFO   = OFF_WFI   + (size_t)2 * DFF * 1024 * 2;
constexpr size_t OFF_STATS = OFF_WFO   + (size_t)1024 * DFF * 2;
constexpr size_t OFF_ROPE  = OFF_STATS + (size_t)ROWS * 2 * 4;
constexpr size_t OFF_MLOGF = OFF_ROPE  + (size_t)8208 * 32 * 2 * 4;
constexpr size_t OFF_MV    = OFF_MLOGF + (size_t)16 * 512 * 4;
constexpr size_t OFF_STATS2= OFF_MV    + (size_t)16 * 512 * 4;
constexpr size_t OFF_DVEC  = OFF_STATS2+ (size_t)ROWS * 2 * 4;
constexpr size_t OFF_R1    = OFF_DVEC  + (size_t)2048 * 128 * 4;
constexpr size_t OFF_HQ    = OFF_R1    + (size_t)ROWS * 1024 * 2;
constexpr size_t OFF_HV    = OFF_HQ    + (size_t)ROWS * 512 * 2;
constexpr size_t OFF_HG    = OFF_HV    + (size_t)ROWS * 512 * 2;
constexpr size_t OFF_AQ    = OFF_HG    + (size_t)ROWS * 512 * 2;
constexpr size_t OFF_AK    = OFF_AQ    + (size_t)ROWS * 512 * 2;
constexpr size_t OFF_AV    = OFF_AK    + (size_t)(ROWS + 16) * 128 * 2;
constexpr size_t OFF_GL    = OFF_AV    + (size_t)(ROWS + 16) * 128 * 2;
constexpr size_t GL_BLOCK  = (size_t)256 * 2048 * 2 + (size_t)256 * 512 * 4;
constexpr size_t GL_LOGF   = (size_t)256 * 2048 * 2;
constexpr size_t OFF_HO    = OFF_GL    + (size_t)NTILE * GL_BLOCK;
constexpr size_t OFF_AO    = OFF_HO    + (size_t)ROWS * 512 * 2;
constexpr size_t WS_END    = OFF_AO    + (size_t)ROWS * 512 * 2;
constexpr size_t DOUT_H0   = (size_t)2048 * 128 * 128 * 4;

constexpr int LDS_BYTES = 144 * 1024;

struct Params {
  const float *x, *meta, *lng, *lnb, *w_in, *hglb, *hgng, *sinks, *w_bhg, *w_batt, *w_out, *ln1g, *ln1b, *w_fi, *w_fo, *ln2g, *ln2b;
  float* out;
  char* ws;
  int ph_lo, ph_hi;
};

typedef __bf16 bf16x2_t __attribute__((ext_vector_type(2)));
typedef float f32x2_t __attribute__((ext_vector_type(2)));
DEVI unsigned pack2(float a, float b) { f32x2_t v = {a, b}; bf16x2_t r = __builtin_convertvector(v, bf16x2_t); return __builtin_bit_cast(unsigned, r); }
DEVI u16 f2bf(float f) { return (u16)(pack2(f, 0.f) & 0xffffu); }
DEVI float bf2f(u16 h) { return __uint_as_float(((unsigned)h) << 16); }
DEVI float bflo(unsigned w) { return __uint_as_float(w << 16); }
DEVI float bfhi(unsigned w) { return __uint_as_float(w & 0xffff0000u); }
DEVI float sigm(float x) { return __builtin_amdgcn_rcpf(1.0f + __expf(-x)); }
DEVI float silu(float x) { return x * sigm(x); }
DEVI float wave_sum(float v) {
#pragma unroll
  for (int o = 32; o; o >>= 1) v += __shfl_xor(v, o);
  return v;
}
DEVI float lb_of(const Params& p, int j) { return 1.0f / (1.0f + __expf(p.hglb[512 + j] - p.hglb[j])); }

DEVI size_t opaque_zero() { size_t z = 0; asm volatile("" : "+s"(z)); return z; }
DEVI char* opaque_ptr(char* q) { return q + opaque_zero(); }
DEVI int opaque_tid() { int t = threadIdx.x; asm volatile("" : "+v"(t)); return t; }

DEVI void rope_cs(int pos, int fi, float& c, float& s) {
  double invd = 1.0;
  if (fi & 1) invd *= 0.7498942093324559;
  if (fi & 2) invd *= 0.5623413251903491;
  if (fi & 4) invd *= 0.31622776601683794;
  if (fi & 8) invd *= 0.1;
  if (fi & 16) invd *= 0.01;
  float inv = (float)invd;
  float ang = (float)pos * inv;
  double a = (double)ang;
  double n = rint(a * 0.15915494309189535);
  double r = fma(-n, 6.283185307179586, a);
  r = fma(-n, 2.4492935982947064e-16, r);
  double r2 = r * r, ts = r, tc = 1.0, ss = r, cc = 1.0;
#pragma unroll
  for (int i = 1; i <= 12; ++i) {
    tc *= -r2 / (double)((2 * i - 1) * (2 * i)); cc += tc;
    ts *= -r2 / (double)((2 * i) * (2 * i + 1)); ss += ts;
  }
  c = (float)cc; s = (float)ss;
}

DEVI void stage_rc(int b, int& R, int& C) {
  int st = b / 1024, sb = b % 1024, swz = sb ^ (((sb >> 9) & 1) << 5);
  R = (st >> 1) * 16 + swz / 64; C = (st & 1) * 32 + (swz % 64) / 2;
}
DEVI int lds_byte(int r, int c) {
  int st = (r >> 4) * 2 + (c >> 5), rr = r & 15, cc = c & 31, ob = rr * 64 + cc * 2;
  return st * 1024 + (ob ^ (((ob >> 9) & 1) << 5));
}

DEVI size_t blk(int K, int tile, int lr, int col) { return (size_t)tile * 256 * K + ((size_t)(col >> 6) * 256 + lr) * 64 + (col & 63); }
DEVI int perm32(int rho) { const int n = rho >> 4, i = rho & 15; return 8 * (i >> 2) + 4 * n + (i & 3); }
DEVI const char* opaque_cptr(const char* q) { return q + opaque_zero(); }

template <int K, class UF, class EF>
DEVI void gemm_stream(const int nunits, UF&& unitf, EF&& epif, char* shm) {
  constexpr int BK = 64, HALF = 128, HTB = HALF * BK * 2;
  if (nunits <= 0) return;
  const int tid = opaque_tid();
  const int wid = tid >> 6, lane = tid & 63, wr = wid >> 2, wc = wid & 3, fr = lane & 15, fq = lane >> 4;
  unsigned voffA0, voffA1, voffB0, voffB1;
  {
    int r0, c0, r1, c1;
    stage_rc(tid * 16, r0, c0); stage_rc(tid * 16 + 8192, r1, c1);
    voffA0 = (unsigned)(r0 * 64 + c0) * 2u; voffA1 = (unsigned)(r1 * 64 + c1) * 2u;
    voffB0 = (unsigned)(((r0 & ~31) + perm32(r0 & 31)) * 64 + c0) * 2u; voffB1 = (unsigned)(((r1 & ~31) + perm32(r1 & 31)) * 64 + c1) * 2u;
  }
  constexpr size_t kstep = (size_t)256 * BK * 2;
  constexpr size_t hstep = (size_t)HALF * BK * 2;
#define SA(b, h) (shm + ((b) * 2 + (h)) * HTB)
#define SB(b, h) (shm + (4 + (b) * 2 + (h)) * HTB)
#define STAGE(P, GBASE, V0, V1) do { const char* _g = opaque_cptr(GBASE); \
    __builtin_amdgcn_global_load_lds((const unsigned*)(_g + (V0)), (unsigned*)((P) + tid * 16), 16, 0, 0); \
    __builtin_amdgcn_global_load_lds((const unsigned*)(_g + (V1)), (unsigned*)((P) + tid * 16 + 8192), 16, 0, 0); } while (0)
#define STAGE_A(P, G) STAGE(P, G, voffA0, voffA1)
#define STAGE_B(P, G) STAGE(P, G, voffB0, voffB1)
#define LDA(dst, b, h) _Pragma("unroll") for (int m = 0; m < 4; ++m) _Pragma("unroll") for (int k = 0; k < 2; ++k) \
    dst[m][k] = *reinterpret_cast<const bf16x8*>(SA(b, h) + lds_byte(wr * 64 + m * 16 + fr, k * 32 + fq * 8))
#define LDB(dst, b, h) _Pragma("unroll") for (int n = 0; n < 2; ++n) _Pragma("unroll") for (int k = 0; k < 2; ++k) \
    dst[n][k] = *reinterpret_cast<const bf16x8*>(SB(b, h) + lds_byte(wc * 32 + n * 16 + fr, k * 32 + fq * 8))
#define MMA(ai, bj, At_, Bt_) do { __builtin_amdgcn_s_setprio(1); \
    _Pragma("unroll") for (int m = 0; m < 4; ++m) _Pragma("unroll") for (int n = 0; n < 2; ++n) _Pragma("unroll") for (int k = 0; k < 2; ++k) \
      acc[ai][bj][m][n] = __builtin_amdgcn_mfma_f32_16x16x32_bf16(Bt_[n][k], At_[m][k], acc[ai][bj][m][n], 0, 0, 0); \
    __builtin_amdgcn_s_setprio(0); } while (0)
#define WAIT_V(n) asm volatile("s_waitcnt vmcnt(" #n ")" ::: "memory")
#define WAIT_L(n) asm volatile("s_waitcnt lgkmcnt(" #n ")" ::: "memory")
#define BAR __builtin_amdgcn_s_barrier()
#define SCHED __builtin_amdgcn_sched_barrier(0)
  f32x4 acc[2][2][4][2];
#pragma unroll
  for (int a = 0; a < 2; ++a)
#pragma unroll
    for (int b = 0; b < 2; ++b)
#pragma unroll
      for (int m = 0; m < 4; ++m)
#pragma unroll
        for (int n = 0; n < 2; ++n) acc[a][b][m][n] = f32x4{0.f, 0.f, 0.f, 0.f};
  bf16x8 At[4][2], B0[2][2], B1[2][2];
  constexpr int nt = K / BK;
  const char* cA; const char* cB;
  unitf(0, cA, cB);
  STAGE_B(SB(0, 0), cB); STAGE_A(SA(0, 0), cA); STAGE_B(SB(0, 1), cB + hstep); STAGE_A(SA(0, 1), cA + hstep);
  if (wr == 1) BAR;
  WAIT_V(4); BAR;
  STAGE_B(SB(1, 0), cB + kstep); STAGE_A(SA(1, 0), cA + kstep); STAGE_B(SB(1, 1), cB + hstep + kstep);
  WAIT_V(6); BAR;
#pragma unroll 1
  for (int ui = 0; ui < nunits; ++ui) {
    const bool has_next = (ui + 1 < nunits);
    const char* nA = cA; const char* nB = cB;
    if (has_next) unitf(ui + 1, nA, nB);
#pragma unroll 1
    for (int t = 0; t < nt; t += 2) {
      const bool last = (t == nt - 2);
      const char* a1 = cA + (size_t)(t + 1) * kstep;
      const char* a2 = last ? nA : cA + (size_t)(t + 2) * kstep;
      const char* b2 = last ? nB : cB + (size_t)(t + 2) * kstep;
      const char* a3 = a2 + kstep; const char* b3 = b2 + kstep;
      LDB(B0, 0, 0); SCHED; LDA(At, 0, 0); STAGE_A(SA(1, 1), a1 + hstep);
      WAIT_L(8); BAR; WAIT_L(0); MMA(0, 0, At, B0); BAR; SCHED;
      LDB(B1, 0, 1); STAGE_B(SB(0, 0), b2);
      BAR; WAIT_L(0); MMA(0, 1, At, B1); BAR;
      LDA(At, 0, 1); STAGE_A(SA(0, 0), a2);
      BAR; WAIT_L(0); MMA(1, 0, At, B0); BAR; SCHED;
      STAGE_B(SB(0, 1), b2 + hstep);
      WAIT_V(6); BAR; MMA(1, 1, At, B1); BAR;
      LDB(B0, 1, 0); SCHED; LDA(At, 1, 0); STAGE_A(SA(0, 1), a2 + hstep);
      WAIT_L(8); BAR; WAIT_L(0); MMA(0, 0, At, B0); BAR; SCHED;
      LDB(B1, 1, 1); STAGE_B(SB(1, 0), b3);
      BAR; WAIT_L(0); MMA(0, 1, At, B1); BAR;
      LDA(At, 1, 1); STAGE_A(SA(1, 0), a3);
      BAR; WAIT_L(0); MMA(1, 0, At, B0); BAR; SCHED;
      STAGE_B(SB(1, 1), b3 + hstep);
      WAIT_V(6); BAR; MMA(1, 1, At, B1); BAR;
    }
    epif(ui, acc, wr, wc, fr, fq);
#pragma unroll
    for (int a = 0; a < 2; ++a)
#pragma unroll
      for (int b = 0; b < 2; ++b)
#pragma unroll
        for (int m = 0; m < 4; ++m)
#pragma unroll
          for (int n = 0; n < 2; ++n) acc[a][b][m][n] = f32x4{0.f, 0.f, 0.f, 0.f};
    cA = nA; cB = nB;
  }
  WAIT_V(0);
  if (wr == 0) BAR;
  BAR;
#undef SA
#undef SB
#undef STAGE
#undef STAGE_A
#undef STAGE_B
#undef LDA
#undef LDB
#undef MMA
}

enum { EPI_ACT = 0, EPI_F, EPI_AQ, EPI_AKV, EPI_ATT, EPI_HG, EPI_OUT, EPI_FFI, EPI_FFO };

DEVI void st_bf8(u16* dst, const float (&y)[8]) {
  uint4 o; o.x = pack2(y[0], y[1]); o.y = pack2(y[2], y[3]); o.z = pack2(y[4], y[5]); o.w = pack2(y[6], y[7]);
  *(uint4*)dst = o;
}
DEVI void ld_bf8(const u16* src, float (&y)[8]) {
  uint4 o = *(const uint4*)src;
  y[0] = bflo(o.x); y[1] = bfhi(o.x); y[2] = bflo(o.y); y[3] = bfhi(o.y); y[4] = bflo(o.z); y[5] = bfhi(o.z); y[6] = bflo(o.w); y[7] = bfhi(o.w);
}
DEVI void ld_f8(const float* src, float (&y)[8]) {
  float4 a = *(const float4*)src, b = *(const float4*)(src + 4);
  y[0] = a.x; y[1] = a.y; y[2] = a.z; y[3] = a.w; y[4] = b.x; y[5] = b.y; y[6] = b.z; y[7] = b.w;
}
DEVI void st_f8(float* dst, const float (&y)[8]) {
  *(float4*)dst = make_float4(y[0], y[1], y[2], y[3]); *(float4*)(dst + 4) = make_float4(y[4], y[5], y[6], y[7]);
}

DEVI void rope8(const float (&x1)[8], const float (&x2)[8], const float4* tab, float sc, float (&y1)[8], float (&y2)[8]) {
#pragma unroll
  for (int e2 = 0; e2 < 4; ++e2) {
    const float4 cs = tab[e2];
    y1[2 * e2] = (x1[2 * e2] * cs.x - x2[2 * e2] * cs.y) * sc;
    y2[2 * e2] = (x2[2 * e2] * cs.x + x1[2 * e2] * cs.y) * sc;
    y1[2 * e2 + 1] = (x1[2 * e2 + 1] * cs.z - x2[2 * e2 + 1] * cs.w) * sc;
    y2[2 * e2 + 1] = (x2[2 * e2 + 1] * cs.z + x1[2 * e2 + 1] * cs.w) * sc;
  }
}

template <int EPI>
DEVI void epi_regs(const Params& p, int mt, int nt, const f32x4 (&acc)[2][2][4][2], int, int, int, int,
                   int mode = 0, u16* dstb = nullptr, int dstride = 0, int dcol = 0) {
  const int tid_ = opaque_tid();
  const int wr = tid_ >> 8, wc = (tid_ >> 6) & 3, fr = tid_ & 15, fq = (tid_ >> 4) & 3;
  char* ws = opaque_ptr(p.ws);
  char* gl = ws + OFF_GL + (size_t)mt * GL_BLOCK;
  const int c0 = wc * 32 + fq * 8;
  float lbv[2][8];
  if (EPI == EPI_F) {
#pragma unroll
    for (int bj = 0; bj < 2; ++bj)
#pragma unroll
      for (int e = 0; e < 8; ++e) lbv[bj][e] = lb_of(p, (nt & 1) * 256 + bj * 128 + c0 + e);
  }
#pragma unroll
  for (int ai = 0; ai < 2; ++ai)
#pragma unroll
    for (int m = 0; m < 4; ++m) {
      const int lr = ai * 128 + wr * 64 + m * 16 + fr;
      const size_t R = (size_t)mt * 256 + lr;
      float va[8], vb[8];
#pragma unroll
      for (int e = 0; e < 4; ++e) { va[e] = acc[ai][0][m][0][e]; va[4 + e] = acc[ai][0][m][1][e]; vb[e] = acc[ai][1][m][0][e]; vb[4 + e] = acc[ai][1][m][1][e]; }
      if (EPI == EPI_AQ) {
        const int hl = c0 >> 5, d0 = c0 & 31;
        const int pos = 16 + (int)(R & 8191);
        const float4* tab = (const float4*)((const float*)(ws + OFF_ROPE) + ((size_t)pos * 32 + d0) * 2);
        float y1[8], y2[8];
        rope8(va, vb, tab, 0.125f, y1, y2);
        u16* dst = (u16*)(ws + OFF_AQ) + R * 512 + (nt & 1) * 256 + hl * 64 + d0;
        st_bf8(dst, y1); st_bf8(dst + 32, y2);
      } else if (EPI == EPI_AKV) {
        if (c0 < 64) {
          const int hl = c0 >> 5, d0 = c0 & 31;
          const int pos = 16 + (int)(R & 8191);
          const float4* tab = (const float4*)((const float*)(ws + OFF_ROPE) + ((size_t)pos * 32 + d0) * 2);
          float y1[8], y2[8];
          rope8(va, vb, tab, 1.0f, y1, y2);
          u16* dst = (u16*)(ws + OFF_AK) + (R + 16) * 128 + hl * 64 + d0;
          st_bf8(dst, y1); st_bf8(dst + 32, y2);
        } else {
          u16* dst = (u16*)(ws + OFF_AV) + (R + 16) * 128 + (c0 - 64);
          st_bf8(dst, va); st_bf8(dst + 64, vb);
        }
      } else if (EPI == EPI_FFI) {
        float y[8];
#pragma unroll
        for (int e = 0; e < 8; ++e) y[e] = silu(va[e]) * vb[e];
        st_bf8((u16*)gl + blk(DFF, 0, lr, nt * 128 + c0), y);
      } else {
#pragma unroll
        for (int bj = 0; bj < 2; ++bj) {
          const int c = bj * 128 + c0;
          float v[8], y[8];
#pragma unroll
          for (int e = 0; e < 8; ++e) v[e] = bj ? vb[e] : va[e];
          if (EPI == EPI_ACT) {
            if (mode == 0) {
#pragma unroll
              for (int e = 0; e < 8; ++e) y[e] = v[e];
            } else {
#pragma unroll
              for (int e = 0; e < 8; ++e) { const float s = sigm(v[e]); y[e] = mode == 1 ? v[e] * s : s; }
            }
            st_bf8(dstb + (size_t)lr * dstride + dcol + c, y);
          } else if (EPI == EPI_F) {
            const int j0 = (nt & 1) * 256 + c;
#pragma unroll
            for (int e = 0; e < 8; ++e) { const float lb = lbv[bj][e]; y[e] = __logf(lb + (1.0f - lb) * sigm(v[e])); }
            st_f8((float*)(gl + GL_LOGF) + lr * 512 + j0, y);
          } else if (EPI == EPI_ATT) {
            const int col = nt * 256 + c;
            float g[8];
            ld_bf8((const u16*)gl + lr * 2048 + 1024 + col, g);
#pragma unroll
            for (int e = 0; e < 8; ++e) y[e] = g[e] * v[e];
            st_f8(p.out + R * 1024 + col, y);
          } else if (EPI == EPI_HG) {
            const int col = nt * 256 + c;
            float g[8], t[8];
            ld_bf8((const u16*)gl + lr * 2048 + col, g);
            ld_f8(p.out + R * 1024 + col, t);
#pragma unroll
            for (int e = 0; e < 8; ++e) y[e] = t[e] + g[e] * v[e];
            st_bf8((u16*)(ws + OFF_R1) + blk(1024, mt, lr, col), y);
          } else if (EPI == EPI_OUT) {
            const int col = nt * 256 + c;
            float xv[8], gm[8], bt[8];
            ld_f8(p.x + R * 1024 + col, xv);
            ld_f8(p.lng + col, gm);
            ld_f8(p.lnb + col, bt);
            const float2 st = *(const float2*)((const float*)(ws + OFF_STATS) + R * 2);
#pragma unroll
            for (int e = 0; e < 8; ++e) y[e] = ALPHA * ((xv[e] - st.x) * st.y * gm[e] + bt[e]) + v[e];
            st_f8(p.out + R * 1024 + col, y);
          } else if (EPI == EPI_FFO) {
            const int col = nt * 256 + c;
            float t[8], gm[8], bt[8];
            ld_f8(p.out + R * 1024 + col, t);
            ld_f8(p.ln1g + col, gm);
            ld_f8(p.ln1b + col, bt);
            const float2 st = *(const float2*)((const float*)(ws + OFF_STATS2) + R * 2);
#pragma unroll
            for (int e = 0; e < 8; ++e) y[e] = ALPHA * ((t[e] - st.x) * st.y * gm[e] + bt[e]) + v[e];
            st_f8(p.out + R * 1024 + col, y);
          }
        }
      }
    }
}


DEVI void ln_rows(const Params& p, int mt, const float* g, const float* b, u16* bfout) {
  const int tid = opaque_tid(), wid = tid >> 6, lane = tid & 63;
#pragma unroll 1
  for (int rr = wid * 4; rr < 256; rr += 32) {
    float4 v[4][4];
#pragma unroll
    for (int q = 0; q < 4; ++q) {
      const float4* row = (const float4*)(p.out + ((size_t)mt * 256 + rr + q) * 1024);
#pragma unroll
      for (int i = 0; i < 4; ++i) v[q][i] = row[i * 64 + lane];
    }
#pragma unroll
    for (int q = 0; q < 4; ++q) {
      const size_t R = (size_t)mt * 256 + rr + q;
      float4* row = (float4*)(p.out + R * 1024);
      float s = 0.f;
#pragma unroll
      for (int i = 0; i < 4; ++i) s += v[q][i].x + v[q][i].y + v[q][i].z + v[q][i].w;
      const float mu = wave_sum(s) * (1.0f / 1024.0f);
      float qq = 0.f;
#pragma unroll
      for (int i = 0; i < 4; ++i) { float a = v[q][i].x - mu, bb = v[q][i].y - mu, c = v[q][i].z - mu, d = v[q][i].w - mu; qq += a * a + bb * bb + c * c + d * d; }
      const float rstd = rsqrtf(wave_sum(qq) * (1.0f / 1024.0f) + EPSF);
      if (bfout && lane == 0) { float* st2 = (float*)(opaque_ptr(p.ws) + OFF_STATS2); st2[R * 2] = mu; st2[R * 2 + 1] = rstd; }
#pragma unroll
      for (int i = 0; i < 4; ++i) {
        float4 g4 = ((const float4*)g)[i * 64 + lane], b4 = ((const float4*)b)[i * 64 + lane];
        float4 y;
        y.x = (v[q][i].x - mu) * rstd * g4.x + b4.x; y.y = (v[q][i].y - mu) * rstd * g4.y + b4.y;
        y.z = (v[q][i].z - mu) * rstd * g4.z + b4.z; y.w = (v[q][i].w - mu) * rstd * g4.w + b4.w;
        if (!bfout) row[i * 64 + lane] = y;
        if (bfout) { uint2 o; o.x = pack2(y.x, y.y); o.y = pack2(y.z, y.w); *(uint2*)(bfout + blk(1024, mt, rr + q, i * 256 + lane * 4)) = o; }
      }
    }
  }
}

DEVI int map_win(int n) {
  if (n < 2048 || n >= 2816) return n;
  if (n < 2560) { const int q = n - 2048, head = q >> 6, d = q & 63; return 2048 + (head >> 2) * 256 + (d >> 5) * 128 + (head & 3) * 32 + (d & 31); }
  if (n < 2688) { const int q = n - 2560, head = q >> 6, d = q & 63; return 2560 + (d >> 5) * 128 + head * 32 + (d & 31); }
  const int q = n - 2688; return 2560 + (q >> 6) * 128 + 64 + (q & 63);
}
DEVI int map_wfi(int n) { return n < DFF ? 256 * (n / 128) + (n % 128) : 256 * ((n - DFF) / 128) + 128 + ((n - DFF) % 128); }

template <int MAP>
DEVI void transpose_tile(const float* __restrict__ src, int K, int N, u16* __restrict__ dst, int k0, int n0, float* tl) {
  const int tid = opaque_tid();
#pragma unroll
  for (int it = 0; it < 8; ++it) { int i = tid + it * NT; int r = i >> 6, c = i & 63; tl[r * 65 + c] = src[(size_t)(k0 + r) * N + n0 + c]; }
  __syncthreads();
#pragma unroll
  for (int it = 0; it < 8; ++it) {
    int i = tid + it * NT; int nn = i >> 6, kk = i & 63;
    const int n = n0 + nn;
    const int dr = MAP == 1 ? map_win(n) : (MAP == 2 ? map_wfi(n) : n);
    dst[blk(K, dr >> 8, dr & 255, k0 + kk)] = f2bf(tl[kk * 65 + nn]);
  }
  __syncthreads();
}

DEVI void phase0(const Params& p, char* smem) {
  const int tid = opaque_tid(), wid = tid >> 6, lane = tid & 63;
  char* ws = opaque_ptr(p.ws);
  {
    float* tl = (float*)smem;
    const bool split_meta = gridDim.x >= 64;
    const int tw = split_meta ? (int)gridDim.x - 20 : (int)gridDim.x;
    for (int t = blockIdx.x; t < 3840 && (int)blockIdx.x < tw; t += tw) {
      if (t < 1216) { int kt = t / 76, ntl = t % 76; transpose_tile<1>(p.w_in, 1024, INW, (u16*)(ws + OFF_WINT), kt * 64, ntl * 64, tl); }
      else if (t < 1344) { int q = t - 1216; int kt = q / 16, ntl = q % 16; transpose_tile<0>(p.w_bhg, 512, 1024, (u16*)(ws + OFF_WBHG), kt * 64, ntl * 64, tl); }
      else if (t < 1472) { int q = t - 1344; int kt = q / 16, ntl = q % 16; transpose_tile<0>(p.w_batt, 512, 1024, (u16*)(ws + OFF_WBATT), kt * 64, ntl * 64, tl); }
      else if (t < 1728) { int q = t - 1472; int kt = q / 16, ntl = q % 16; transpose_tile<0>(p.w_out, 1024, 1024, (u16*)(ws + OFF_WOUT), kt * 64, ntl * 64, tl); }
      else if (t < 3136) { int q = t - 1728; int kt = q / 88, ntl = q % 88; transpose_tile<2>(p.w_fi, 1024, 2 * DFF, (u16*)(ws + OFF_WFI), kt * 64, ntl * 64, tl); }
      else { int q = t - 3136; int kt = q / 16, ntl = q % 16; transpose_tile<0>(p.w_fo, DFF, 1024, (u16*)(ws + OFF_WFO), kt * 64, ntl * 64, tl); }
    }
  }
  {
    u16* h0 = (u16*)((char*)p.out + DOUT_H0);
    float* stats = (float*)(ws + OFF_STATS);
    for (int R0 = (blockIdx.x * 8 + wid) * 2; R0 < ROWS; R0 += gridDim.x * 16) {
      float4 v[2][4];
#pragma unroll
      for (int q = 0; q < 2; ++q) {
        const float4* xr = (const float4*)(p.x + (size_t)(R0 + q) * 1024);
#pragma unroll
        for (int i = 0; i < 4; ++i) v[q][i] = xr[i * 64 + lane];
      }
#pragma unroll
      for (int q = 0; q < 2; ++q) {
        const int R = R0 + q;
        float s = 0.f;
#pragma unroll
        for (int i = 0; i < 4; ++i) s += v[q][i].x + v[q][i].y + v[q][i].z + v[q][i].w;
        const float mu = wave_sum(s) * (1.0f / 1024.0f);
        float qq = 0.f;
#pragma unroll
        for (int i = 0; i < 4; ++i) { float a = v[q][i].x - mu, bb = v[q][i].y - mu, c = v[q][i].z - mu, d = v[q][i].w - mu; qq += a * a + bb * bb + c * c + d * d; }
        const float rstd = rsqrtf(wave_sum(qq) * (1.0f / 1024.0f) + EPSF);
#pragma unroll
        for (int i = 0; i < 4; ++i) {
          float4 g4 = ((const float4*)p.lng)[i * 64 + lane], b4 = ((const float4*)p.lnb)[i * 64 + lane];
          uint2 o;
          o.x = pack2((v[q][i].x - mu) * rstd * g4.x + b4.x, (v[q][i].y - mu) * rstd * g4.y + b4.y);
          o.y = pack2((v[q][i].z - mu) * rstd * g4.z + b4.z, (v[q][i].w - mu) * rstd * g4.w + b4.w);
          *(uint2*)(h0 + blk(1024, R >> 8, R & 255, i * 256 + lane * 4)) = o;
        }
        if (lane == 0) { stats[(size_t)R * 2] = mu; stats[(size_t)R * 2 + 1] = rstd; }
      }
    }
  }
  {
    float2* tab = (float2*)(ws + OFF_ROPE);
    for (int i = blockIdx.x * NT + tid; i < 8208 * 32; i += gridDim.x * NT) {
      float c, s; rope_cs(i >> 5, i & 31, c, s);
      tab[i] = make_float2(c, s);
    }
  }
  {
    float* hm = (float*)smem;
    float* red = (float*)(smem + 65536);
    float* outb = (float*)(smem + 65536 + 32768);
    const bool split_meta = gridDim.x >= 64;
    const int g0 = split_meta ? (int)blockIdx.x - ((int)gridDim.x - 20) : (int)blockIdx.x;
    for (int g = g0; g >= 0 && g < 20; g += (split_meta ? 20 : (int)gridDim.x)) {
      __syncthreads();
      for (int rr = 0; rr < 2; ++rr) {
        const int row = wid * 2 + rr;
        const float4* xr = (const float4*)(p.meta + (size_t)row * 1024);
        float4 v[4];
#pragma unroll
        for (int i = 0; i < 4; ++i) v[i] = xr[i * 64 + lane];
        float s = 0.f;
#pragma unroll
        for (int i = 0; i < 4; ++i) s += v[i].x + v[i].y + v[i].z + v[i].w;
        const float mu = wave_sum(s) * (1.0f / 1024.0f);
        float q = 0.f;
#pragma unroll
        for (int i = 0; i < 4; ++i) { float a = v[i].x - mu, bb = v[i].y - mu, c = v[i].z - mu, d = v[i].w - mu; q += a * a + bb * bb + c * c + d * d; }
        const float rstd = rsqrtf(wave_sum(q) * (1.0f / 1024.0f) + EPSF);
#pragma unroll
        for (int i = 0; i < 4; ++i) {
          float4 g4 = ((const float4*)p.lng)[i * 64 + lane], b4 = ((const float4*)p.lnb)[i * 64 + lane];
          const int k = i * 256 + lane * 4;
          hm[(k + 0) * 16 + row] = (v[i].x - mu) * rstd * g4.x + b4.x;
          hm[(k + 1) * 16 + row] = (v[i].y - mu) * rstd * g4.y + b4.y;
          hm[(k + 2) * 16 + row] = (v[i].z - mu) * rstd * g4.z + b4.z;
          hm[(k + 3) * 16 + row] = (v[i].w - mu) * rstd * g4.w + b4.w;
        }
      }
      __syncthreads();
      const int colbase = g < 8 ? 512 + g * 64 : g < 16 ? 1024 + (g - 8) * 64 : g < 18 ? 2560 + (g - 16) * 64 : 2688 + (g - 18) * 64;
      const int col = colbase + lane;
      float a0 = 0, a1 = 0, a2 = 0, a3 = 0, a4 = 0, a5 = 0, a6 = 0, a7 = 0, a8 = 0, a9 = 0, a10 = 0, a11 = 0, a12 = 0, a13 = 0, a14 = 0, a15 = 0;
#pragma unroll 4
      for (int k = wid * 128; k < wid * 128 + 128; ++k) {
        const float wv = p.w_in[(size_t)k * INW + col];
        const float4* h4 = (const float4*)(hm + k * 16);
        const float4 A = h4[0], B = h4[1], C = h4[2], D = h4[3];
        a0 += A.x * wv; a1 += A.y * wv; a2 += A.z * wv; a3 += A.w * wv;
        a4 += B.x * wv; a5 += B.y * wv; a6 += B.z * wv; a7 += B.w * wv;
        a8 += C.x * wv; a9 += C.y * wv; a10 += C.z * wv; a11 += C.w * wv;
        a12 += D.x * wv; a13 += D.y * wv; a14 += D.z * wv; a15 += D.w * wv;
      }
      float* rw = red + (wid * 16) * 64 + lane;
      rw[0 * 64] = a0; rw[1 * 64] = a1; rw[2 * 64] = a2; rw[3 * 64] = a3; rw[4 * 64] = a4; rw[5 * 64] = a5; rw[6 * 64] = a6; rw[7 * 64] = a7;
      rw[8 * 64] = a8; rw[9 * 64] = a9; rw[10 * 64] = a10; rw[11 * 64] = a11; rw[12 * 64] = a12; rw[13 * 64] = a13; rw[14 * 64] = a14; rw[15 * 64] = a15;
      __syncthreads();
      for (int i = tid; i < 1024; i += NT) {
        const int r = i >> 6, l = i & 63;
        float s = 0.f;
#pragma unroll
        for (int w = 0; w < 8; ++w) s += red[(w * 16 + r) * 64 + l];
        outb[r * 64 + l] = s;
      }
      __syncthreads();
      for (int i = tid; i < 1024; i += NT) {
        const int r = i >> 6, l = i & 63;
        const float val = outb[r * 64 + l];
        if (g < 8) {
          const int j = g * 64 + l; const float lb = lb_of(p, j);
          ((float*)(ws + OFF_MLOGF))[r * 512 + j] = __logf(lb + (1.0f - lb) * sigm(val));
        } else if (g < 16) {
          ((float*)(ws + OFF_MV))[r * 512 + (g - 8) * 64 + l] = val;
        } else if (g < 18) {
          float c, s; rope_cs(r, l & 31, c, s);
          const float other = outb[r * 64 + (l ^ 32)];
          const float y = (l < 32) ? val * c - other * s : val * c + other * s;
          ((u16*)(ws + OFF_AK))[r * 128 + (g - 16) * 64 + l] = f2bf(y);
        } else {
          ((u16*)(ws + OFF_AV))[r * 128 + (g - 18) * 64 + l] = f2bf(val);
        }
      }
      __syncthreads();
    }
  }
}

constexpr int HST = 136;

DEVI void load_vt(const u16* __restrict__ hv, size_t R0, int h, u16* Vt) {
  const int tid = opaque_tid();
  const int d = tid & 127, seg = tid >> 7;
  unsigned vv[32];
#pragma unroll
  for (int i = 0; i < 32; ++i) vv[i] = hv[(R0 + seg * 32 + i) * 512 + h * 128 + d];
#pragma unroll
  for (int i = 0; i < 32; i += 2) *(unsigned*)(Vt + d * HST + seg * 32 + i) = vv[i] | (vv[i + 1] << 16);
}

DEVI void hgrn_local(const Params& p, int mt, char* smem) {
  const int tid = opaque_tid(), wid = tid >> 6, lane = tid & 63, fr = lane & 15, fq = lane >> 4;
  char* ws = opaque_ptr(p.ws);
  u16* At = (u16*)smem;
  u16* Vt = (u16*)(smem + 128 * HST * 2);
  float* tot = (float*)(smem + 2 * 128 * HST * 2);
  const float* logf = (const float*)(ws + OFF_GL + (size_t)mt * GL_BLOCK + GL_LOGF);
  const u16* hv = (const u16*)(ws + OFF_HV);
  float* U = p.out;
  float* dvec = (float*)(ws + OFF_DVEC);
#pragma unroll 1
  for (int un = 0; un < 8; ++un) {
    const int cl = un >> 2, h = un & 3;
    const size_t R0 = (size_t)mt * 256 + cl * 128;
    const int u = (mt * 2 + cl) * 4 + h;
    const int k = tid & 127, seg = tid >> 7;
    const float* lfp = logf + (cl * 128 + seg * 32) * 512 + h * 128 + k;
    float lf[32];
#pragma unroll
    for (int i = 0; i < 32; ++i) lf[i] = lfp[i * 512];
    load_vt(hv, R0, h, Vt);
    float T = 0.f;
#pragma unroll
    for (int i = 0; i < 32; ++i) T += lf[i];
    tot[seg * 128 + k] = T;
    __syncthreads();
    float run = 0.f;
#pragma unroll
    for (int s2 = 3; s2 >= 1; --s2) if (s2 > seg) run += tot[s2 * 128 + k];
#pragma unroll
    for (int i = 31; i >= 1; i -= 2) {
      const float l1 = lf[i], l0 = lf[i - 1];
      const float a1 = (1.0f - __expf(l1)) * __expf(run);
      run += l1;
      const float a0 = (1.0f - __expf(l0)) * __expf(run);
      run += l0;
      *(unsigned*)(At + k * HST + seg * 32 + i - 1) = pack2(a0, a1);
    }
    if (seg == 0) dvec[(size_t)u * 128 + k] = __expf(run);
    __syncthreads();
    f32x4 acc[8];
#pragma unroll
    for (int j = 0; j < 8; ++j) acc[j] = f32x4{0.f, 0.f, 0.f, 0.f};
#pragma unroll
    for (int ks = 0; ks < 4; ++ks) {
      const bf16x8 a = *(const bf16x8*)(Vt + (wid * 16 + fr) * HST + ks * 32 + fq * 8);
#pragma unroll
      for (int j = 0; j < 8; ++j) {
        const bf16x8 b = *(const bf16x8*)(At + (j * 16 + fr) * HST + ks * 32 + fq * 8);
        acc[j] = __builtin_amdgcn_mfma_f32_16x16x32_bf16(a, b, acc[j], 0, 0, 0);
      }
    }
    float* Uu = U + (size_t)u * 16384;
#pragma unroll
    for (int j = 0; j < 8; ++j)
#pragma unroll
      for (int r = 0; r < 4; ++r) Uu[(wid * 16 + fq * 4 + r) * 128 + j * 16 + fr] = acc[j][r];
    __syncthreads();
  }
}

DEVI void hgrn_scan(const Params& p) {
  char* ws = opaque_ptr(p.ws);
  const float* mlogf = (const float*)(ws + OFF_MLOGF);
  const float* mv = (const float*)(ws + OFF_MV);
  const float* U = p.out;
  const float* dvec = (const float*)(ws + OFF_DVEC);
  for (int idx = blockIdx.x * NT + opaque_tid(); idx < 131072; idx += gridDim.x * NT) {
    const int k4 = idx & 31, v = (idx >> 5) & 127, bh = idx >> 12, b = bh >> 2, h = bh & 3;
    float S[4] = {0.f, 0.f, 0.f, 0.f};
    float run[4] = {0.f, 0.f, 0.f, 0.f};
#pragma unroll
    for (int j = 15; j >= 0; --j) {
      const float4 lf = *(const float4*)(mlogf + j * 512 + h * 128 + k4 * 4);
      const float vv = mv[j * 512 + h * 128 + v];
      S[0] += (1.0f - __expf(lf.x)) * __expf(run[0]) * vv; run[0] += lf.x;
      S[1] += (1.0f - __expf(lf.y)) * __expf(run[1]) * vv; run[1] += lf.y;
      S[2] += (1.0f - __expf(lf.z)) * __expf(run[2]) * vv; run[2] += lf.z;
      S[3] += (1.0f - __expf(lf.w)) * __expf(run[3]) * vv; run[3] += lf.w;
    }
#pragma unroll 8
    for (int c = 0; c < 64; ++c) {
      const int gc = b * 64 + c;
      const int u = gc * 4 + h;
      const int mt = gc >> 1, cl = gc & 1;
      u16* dst = (u16*)(ws + OFF_R1 + (size_t)mt * 524288) + ((cl * 4 + h) * 16384 + v * 128 + k4 * 4);
      uint2 o; o.x = pack2(S[0], S[1]); o.y = pack2(S[2], S[3]);
      *(uint2*)dst = o;
      const float4 uu = *(const float4*)(U + (size_t)u * 16384 + v * 128 + k4 * 4);
      const float4 dd = *(const float4*)(dvec + (size_t)u * 128 + k4 * 4);
      S[0] = dd.x * S[0] + uu.x; S[1] = dd.y * S[1] + uu.y; S[2] = dd.z * S[2] + uu.z; S[3] = dd.w * S[3] + uu.w;
    }
  }
}

DEVI void hgrn_out(const Params& p, int mt, char* smem) {
  const int tid = opaque_tid(), wid = tid >> 6, lane = tid & 63, fr = lane & 15, fq = lane >> 4;
  char* ws = opaque_ptr(p.ws);
  u16* Qb = (u16*)smem;
  u16* Q1 = Qb + 128 * HST;
  u16* K0 = Q1 + 64 * HST;
  u16* K1 = K0 + 64 * HST;
  u16* Vt = K1 + 128 * HST;
  float* tot = (float*)(Vt + 128 * HST);
  const float* logf = (const float*)(ws + OFF_GL + (size_t)mt * GL_BLOCK + GL_LOGF);
  const u16* hq = (const u16*)(ws + OFF_HQ);
  const u16* hv = (const u16*)(ws + OFF_HV);
  const u16* hg = (const u16*)(ws + OFF_HG);
  u16* ho = (u16*)(ws + OFF_HO);
#pragma unroll 1
  for (int un = 0; un < 8; ++un) {
    const int cl = un >> 2, h = un & 3;
    const size_t R0 = (size_t)mt * 256 + cl * 128;
    const u16* St = (const u16*)(ws + OFF_R1 + (size_t)mt * 524288) + (cl * 4 + h) * 16384;
    bf16x8 sb[2][8];
    {
      const int k = tid & 127, seg = tid >> 7;
      const float* lfp = logf + (cl * 128 + seg * 32) * 512 + h * 128 + k;
      const u16* qp_ = hq + (R0 + seg * 32) * 512 + h * 128 + k;
      float lf[32]; unsigned qr[32];
#pragma unroll
      for (int i = 0; i < 32; ++i) { lf[i] = lfp[i * 512]; qr[i] = qp_[i * 512]; }
#pragma unroll
      for (int ks = 0; ks < 2; ++ks)
#pragma unroll
        for (int j = 0; j < 8; ++j) sb[ks][j] = *(const bf16x8*)(St + (j * 16 + fr) * 128 + ks * 32 + fq * 8);
      load_vt(hv, R0, h, Vt);
      float T = 0.f;
#pragma unroll
      for (int i = 0; i < 32; ++i) T += lf[i];
      tot[seg * 128 + k] = T;
      __syncthreads();
      float run = 0.f;
#pragma unroll
      for (int s2 = 0; s2 < 3; ++s2) if (s2 < seg) run += tot[s2 * 128 + k];
      const float r1 = tot[k] + tot[128 + k];
      const bool hi = seg >= 2;
      u16* xdst = hi ? (Q1 + (seg * 32 - 64) * HST + k) : (K0 + (seg * 32) * HST + k);
#pragma unroll
      for (int i = 0; i < 32; ++i) {
        const int t = seg * 32 + i;
        const float l = lf[i];
        run += l;
        const float qv = __uint_as_float(qr[i] << 16);
        const float kk = 1.0f - __expf(l);
        Qb[t * HST + k] = f2bf(qv * __expf(run));
        K1[t * HST + k] = f2bf(kk * __expf(r1 - run));
        xdst[i * HST] = f2bf((hi ? qv : kk) * __expf(hi ? (run - r1) : -run));
      }
    }
    __syncthreads();
    f32x4 acc[8];
#pragma unroll
    for (int j = 0; j < 8; ++j) acc[j] = f32x4{0.f, 0.f, 0.f, 0.f};
    {
      bf16x8 sc[2][8];
#pragma unroll
      for (int ks = 0; ks < 2; ++ks)
#pragma unroll
        for (int j = 0; j < 8; ++j) sc[ks][j] = *(const bf16x8*)(St + (j * 16 + fr) * 128 + (ks + 2) * 32 + fq * 8);
#pragma unroll
      for (int ks = 0; ks < 2; ++ks) {
        const bf16x8 a = *(const bf16x8*)(Qb + (wid * 16 + fr) * HST + ks * 32 + fq * 8);
#pragma unroll
        for (int j = 0; j < 8; ++j) acc[j] = __builtin_amdgcn_mfma_f32_16x16x32_bf16(a, sb[ks][j], acc[j], 0, 0, 0);
      }
#pragma unroll
      for (int ks = 0; ks < 2; ++ks) {
        const bf16x8 a = *(const bf16x8*)(Qb + (wid * 16 + fr) * HST + (ks + 2) * 32 + fq * 8);
#pragma unroll
        for (int j = 0; j < 8; ++j) acc[j] = __builtin_amdgcn_mfma_f32_16x16x32_bf16(a, sc[ks][j], acc[j], 0, 0, 0);
      }
    }
    {
      const int H = wid >> 2;
      const u16* Qsrc = H ? (Q1 + ((wid - 4) * 16 + fr) * HST) : (Qb + (wid * 16 + fr) * HST);
      const u16* Ksrc = H ? K1 : K0;
      bf16x8 qf[4];
      bf16x4 vlo[8], vhi[8];
#pragma unroll
      for (int ks = 0; ks < 4; ++ks) qf[ks] = *(const bf16x8*)(Qsrc + ks * 32 + fq * 8);
#pragma unroll
      for (int g = 0; g < 4; ++g) {
        if (2 * g <= wid) {
          f32x4 s0 = f32x4{0.f, 0.f, 0.f, 0.f}, s1 = f32x4{0.f, 0.f, 0.f, 0.f};
          {
            bf16x8 ka[4], kb[4];
            const bool two = (2 * g + 1 <= wid);
#pragma unroll
            for (int ks = 0; ks < 4; ++ks) {
              ka[ks] = *(const bf16x8*)(Ksrc + ((2 * g) * 16 + fr) * HST + ks * 32 + fq * 8);
              kb[ks] = *(const bf16x8*)(Ksrc + ((two ? 2 * g + 1 : 2 * g) * 16 + fr) * HST + ks * 32 + fq * 8);
            }
#pragma unroll
            for (int j = 0; j < 8; ++j) {
              const u16* vp = Vt + (j * 16 + fr) * HST + g * 32 + fq * 4;
              vlo[j] = *(const bf16x4*)vp; vhi[j] = *(const bf16x4*)(vp + 16);
            }
#pragma unroll
            for (int ks = 0; ks < 4; ++ks) s0 = __builtin_amdgcn_mfma_f32_16x16x32_bf16(ka[ks], qf[ks], s0, 0, 0, 0);
#pragma unroll
            for (int ks = 0; ks < 4; ++ks) s1 = __builtin_amdgcn_mfma_f32_16x16x32_bf16(kb[ks], qf[ks], s1, 0, 0, 0);
            if (!two) s1 = f32x4{0.f, 0.f, 0.f, 0.f};
          }
          if (2 * g == wid) {
#pragma unroll
            for (int r = 0; r < 4; ++r) if (fq * 4 + r > fr) s0[r] = 0.f;
          }
          if (2 * g + 1 == wid) {
#pragma unroll
            for (int r = 0; r < 4; ++r) if (fq * 4 + r > fr) s1[r] = 0.f;
          }
          bf16x8 pf;
          pf[0] = (short)f2bf(s0[0]); pf[1] = (short)f2bf(s0[1]); pf[2] = (short)f2bf(s0[2]); pf[3] = (short)f2bf(s0[3]);
          pf[4] = (short)f2bf(s1[0]); pf[5] = (short)f2bf(s1[1]); pf[6] = (short)f2bf(s1[2]); pf[7] = (short)f2bf(s1[3]);
#pragma unroll
          for (int j = 0; j < 8; ++j) {
            bf16x8 b;
            b[0] = vlo[j][0]; b[1] = vlo[j][1]; b[2] = vlo[j][2]; b[3] = vlo[j][3]; b[4] = vhi[j][0]; b[5] = vhi[j][1]; b[6] = vhi[j][2]; b[7] = vhi[j][3];
            acc[j] = __builtin_amdgcn_mfma_f32_16x16x32_bf16(pf, b, acc[j], 0, 0, 0);
          }
        }
      }
    }
    __syncthreads();
    {
      float ss[4];
#pragma unroll
      for (int r = 0; r < 4; ++r) {
        float s = 0.f;
#pragma unroll
        for (int j = 0; j < 8; ++j) s += acc[j][r] * acc[j][r];
        s += __shfl_xor(s, 1); s += __shfl_xor(s, 2); s += __shfl_xor(s, 4); s += __shfl_xor(s, 8);
        ss[r] = rsqrtf(s * (1.0f / 128.0f) + EPSF);
      }
#pragma unroll
      for (int j = 0; j < 8; ++j) {
        const float ng = p.hgng[j * 16 + fr];
#pragma unroll
        for (int r = 0; r < 4; ++r) {
          const size_t off = (R0 + wid * 16 + fq * 4 + r) * 512 + h * 128 + j * 16 + fr;
          ho[blk(512, mt, cl * 128 + wid * 16 + fq * 4 + r, h * 128 + j * 16 + fr)] = f2bf(acc[j][r] * ss[r] * ng * bf2f(hg[off]));
        }
      }
    }
    __syncthreads();
  }
}

constexpr int KST = 72;
constexpr int VST = 296;
DEVI void attention(const Params& p, int mt, char* smem) {
  const int tid = opaque_tid(), wid = tid >> 6, lane = tid & 63, fr = lane & 15, fq = lane >> 4;
  char* ws = opaque_ptr(p.ws);
  u16* Ks = (u16*)smem;
  u16* Vt = (u16*)(smem + 272 * KST * 2);
  const u16* aq = (const u16*)(ws + OFF_AQ);
  const u16* ak = (const u16*)(ws + OFF_AK);
  const u16* av = (const u16*)(ws + OFF_AV);
  u16* ao = (u16*)(ws + OFF_AO);
#pragma unroll 1
  for (int un = 0; un < 4; ++un) {
    const int cl = un >> 1, kvh = un & 1;
    const size_t R0 = (size_t)mt * 256 + cl * 128;
    const bool has_prev = (R0 & 8191) != 0;
    auto krow_of = [&](int kk) -> size_t {
      if (kk < 16) return (size_t)kk;
      if (kk < 144) return has_prev ? (16 + R0 - 128 + (kk - 16)) : (16 + R0 + (kk - 16));
      return 16 + R0 + (kk - 144);
    };
#pragma unroll
    for (int it = 0; it < 5; ++it) {
      const int i = it * NT + tid;
      if (i >= 272 * 8) break;
      const int kk = i >> 3, ch = i & 7;
      const uint4 kv = *(const uint4*)(ak + krow_of(kk) * 128 + kvh * 64 + ch * 8);
      *(uint4*)(Ks + kk * KST + ch * 8) = kv;
    }
#pragma unroll
    for (int it = 0; it < 3; ++it) {
      const int i = it * NT + tid;
      if (i >= 136 * 8) break;
      const int kp = i % 136, ch = i / 136;
      const uint4 v0 = *(const uint4*)(av + krow_of(2 * kp) * 128 + kvh * 64 + ch * 8);
      const uint4 v1 = *(const uint4*)(av + krow_of(2 * kp + 1) * 128 + kvh * 64 + ch * 8);
      unsigned* vd = (unsigned*)(Vt + (ch * 8) * VST + 2 * kp);
      constexpr int VS2 = VST / 2;
      vd[0 * VS2] = (v0.x & 0xffffu) | (v1.x << 16); vd[1 * VS2] = (v0.x >> 16) | (v1.x & 0xffff0000u);
      vd[2 * VS2] = (v0.y & 0xffffu) | (v1.y << 16); vd[3 * VS2] = (v0.y >> 16) | (v1.y & 0xffff0000u);
      vd[4 * VS2] = (v0.z & 0xffffu) | (v1.z << 16); vd[5 * VS2] = (v0.z >> 16) | (v1.z & 0xffff0000u);
      vd[6 * VS2] = (v0.w & 0xffffu) | (v1.w << 16); vd[7 * VS2] = (v0.w >> 16) | (v1.w & 0xffff0000u);
    }
    __syncthreads();
    const int qt = wid;
    const int iq = qt * 16 + fr;
    const int lo = has_prev ? (iq + 1) : max(iq + 1, 128);
    const unsigned hi_lo = (unsigned)(iq + 128 - lo);
#pragma unroll 1
    for (int g = 0; g < 4; ++g) {
      asm volatile("" ::: "memory");
      const int hq = kvh * 4 + g;
      const float sink = p.sinks[hq];
      const u16* qp = aq + (R0 + qt * 16 + fr) * 512 + hq * 64 + fq * 8;
      const bf16x8 qf0 = *(const bf16x8*)qp;
      const bf16x8 qf1 = *(const bf16x8*)(qp + 32);
      f32x4 sT[10];
#pragma unroll
      for (int ih = 0; ih < 2; ++ih) {
        bf16x8 k0[5], k1[5];
#pragma unroll
        for (int ii = 0; ii < 5; ++ii) {
          const int i = ih * 5 + ii;
          const int krow = (i < 9) ? (16 + (qt + i) * 16) : 0;
          const u16* kp = Ks + (krow + fr) * KST + fq * 8;
          k0[ii] = *(const bf16x8*)kp; k1[ii] = *(const bf16x8*)(kp + 32);
        }
#pragma unroll
        for (int ii = 0; ii < 5; ++ii) {
          f32x4 s = f32x4{0.f, 0.f, 0.f, 0.f};
          s = __builtin_amdgcn_mfma_f32_16x16x32_bf16(k0[ii], qf0, s, 0, 0, 0);
          s = __builtin_amdgcn_mfma_f32_16x16x32_bf16(k1[ii], qf1, s, 0, 0, 0);
          sT[ih * 5 + ii] = s;
        }
      }
      float m = sink;
#pragma unroll
      for (int i = 0; i < 9; ++i)
#pragma unroll
        for (int r = 0; r < 4; ++r) {
          if (i == 0 || i == 8 || !has_prev) {
            const int jb = (qt + i) * 16 + fq * 4 + r;
            const bool ok = (unsigned)(jb - lo) <= hi_lo;
            sT[i][r] = ok ? sT[i][r] : -3.0e38f;
          }
          m = fmaxf(m, sT[i][r]);
        }
#pragma unroll
      for (int r = 0; r < 4; ++r) m = fmaxf(m, sT[9][r]);
      m = fmaxf(m, __shfl_xor(m, 16)); m = fmaxf(m, __shfl_xor(m, 32));
      float l = 0.f;
#pragma unroll
      for (int i = 0; i < 10; ++i)
#pragma unroll
        for (int r = 0; r < 4; ++r) {
          const float e = __expf(sT[i][r] - m);
          sT[i][r] = e; l += e;
        }
      l += __shfl_xor(l, 16); l += __shfl_xor(l, 32);
      l += __expf(sink - m);
      const float linv = 1.0f / l;
      f32x4 o[4];
#pragma unroll
      for (int dt = 0; dt < 4; ++dt) o[dt] = f32x4{0.f, 0.f, 0.f, 0.f};
#pragma unroll
      for (int gp = 0; gp < 5; ++gp) {
        const int ia = 2 * gp, ib = 2 * gp + 1;
        const int krowa = 16 + (qt + ia) * 16;
        const int krowb = (ib < 9) ? (16 + (qt + ib) * 16) : 0;
        bf16x8 pf;
        pf[0] = (short)f2bf(sT[ia][0]); pf[1] = (short)f2bf(sT[ia][1]); pf[2] = (short)f2bf(sT[ia][2]); pf[3] = (short)f2bf(sT[ia][3]);
        pf[4] = (short)f2bf(sT[ib][0]); pf[5] = (short)f2bf(sT[ib][1]); pf[6] = (short)f2bf(sT[ib][2]); pf[7] = (short)f2bf(sT[ib][3]);
        bf16x4 v0[4], v1[4];
#pragma unroll
        for (int dt = 0; dt < 4; ++dt) {
          const u16* vp = Vt + (dt * 16 + fr) * VST + fq * 4;
          v0[dt] = *(const bf16x4*)(vp + krowa); v1[dt] = *(const bf16x4*)(vp + krowb);
        }
#pragma unroll
        for (int dt = 0; dt < 4; ++dt) {
          bf16x8 b;
          b[0] = v0[dt][0]; b[1] = v0[dt][1]; b[2] = v0[dt][2]; b[3] = v0[dt][3]; b[4] = v1[dt][0]; b[5] = v1[dt][1]; b[6] = v1[dt][2]; b[7] = v1[dt][3];
          o[dt] = __builtin_amdgcn_mfma_f32_16x16x32_bf16(pf, b, o[dt], 0, 0, 0);
        }
      }
#pragma unroll
      for (int r = 0; r < 4; ++r) {
        const float li = __shfl(linv, fq * 4 + r);
#pragma unroll
        for (int dt = 0; dt < 4; ++dt)
          ao[blk(512, mt, cl * 128 + qt * 16 + fq * 4 + r, hq * 64 + dt * 16 + fr)] = f2bf(o[dt][r] * li);
      }
    }
    __syncthreads();
  }
}

DEVI bool unit_of(int i, int nN, int& pm, int& pn) {
  const int nwg = NTILE * nN;
  const int L = i * (int)gridDim.x + (int)blockIdx.x;
  if (L >= nwg) return false;
  const int q = nwg >> 3;
  const int wgid = (L & 7) * q + (L >> 3);
  const int nig = 8 * nN, gid = wgid / nig, rem = wgid - gid * nig;
  pm = gid * 8 + (rem & 7); pn = rem >> 3;
  return true;
}
DEVI int units_of(int nN) { const int nwg = NTILE * nN; const int c = blockIdx.x, G = gridDim.x; return c < nwg ? (nwg - c + G - 1) / G : 0; }

__global__ void __launch_bounds__(NT, 2) fwd_megakernel(Params p) {
  extern __shared__ __attribute__((aligned(16))) char smem[];
  cg::grid_group grid = cg::this_grid();
  for (int ph = p.ph_lo; ph < p.ph_hi; ++ph) {
    if (ph > p.ph_lo) grid.sync();
    char* ws = opaque_ptr(p.ws);
    if (ph == 0) {
      phase0(p, smem);
    } else if (ph == 1) {
      {
      const char* h0b = (const char*)p.out + DOUT_H0;
      const char* wint = ws + OFF_WINT;
      gemm_stream<1024>(units_of(19),
        [&](int i, const char*& A, const char*& B) { int pm, pn; unit_of(i, 19, pm, pn); A = h0b + (size_t)pm * 256 * 1024 * 2; B = wint + (size_t)pn * 256 * 1024 * 2; },
        [&](int i, const f32x4 (&acc)[2][2][4][2], int wr, int wc, int fr, int fq) {
          int mt, nt; unit_of(i, 19, mt, nt);
          char* w2 = opaque_ptr(p.ws);
          if (nt == 2 || nt == 3) epi_regs<EPI_F>(p, mt, nt, acc, wr, wc, fr, fq);
          else if (nt == 8 || nt == 9) epi_regs<EPI_AQ>(p, mt, nt, acc, wr, wc, fr, fq);
          else if (nt == 10) epi_regs<EPI_AKV>(p, mt, nt, acc, wr, wc, fr, fq);
          else {
            int mode, dstride, dcol; u16* dstb;
            if (nt < 2) { mode = 1; dstb = (u16*)(w2 + OFF_HQ) + (size_t)mt * 256 * 512; dstride = 512; dcol = nt * 256; }
            else if (nt < 6) { mode = 0; dstb = (u16*)(w2 + OFF_HV) + (size_t)mt * 256 * 512; dstride = 512; dcol = (nt - 4) * 256; }
            else if (nt < 8) { mode = 1; dstb = (u16*)(w2 + OFF_HG) + (size_t)mt * 256 * 512; dstride = 512; dcol = (nt - 6) * 256; }
            else { mode = 2; dstb = (u16*)(w2 + OFF_GL + (size_t)mt * GL_BLOCK); dstride = 2048; dcol = (nt - 11) * 256; }
            epi_regs<EPI_ACT>(p, mt, nt, acc, wr, wc, fr, fq, mode, dstb, dstride, dcol);
          }
        }, smem);
      __syncthreads();
      }
    } else if (ph == 2) {
      for (int mt = blockIdx.x; mt < NTILE; mt += gridDim.x) {
        __syncthreads();
        attention(p, mt, smem);
        hgrn_local(p, mt, smem);
      }
    } else if (ph == 3) {
      hgrn_scan(p);
    } else if (ph == 4) {
      for (int mt = blockIdx.x; mt < NTILE; mt += gridDim.x) {
        __syncthreads();
        hgrn_out(p, mt, smem);
        __syncthreads();
        {
          const char* ao = ws + OFF_AO + (size_t)mt * 256 * 512 * 2; const char* ho = ws + OFF_HO + (size_t)mt * 256 * 512 * 2;
          const char* wa = ws + OFF_WBATT; const char* wh = ws + OFF_WBHG;
          gemm_stream<512>(8,
            [&](int i, const char*& A, const char*& B) { A = (i & 1) ? ho : ao; B = ((i & 1) ? wh : wa) + (size_t)(i >> 1) * 256 * 512 * 2; },
            [&](int i, const f32x4 (&acc)[2][2][4][2], int wr, int wc, int fr, int fq) {
              if (i & 1) epi_regs<EPI_HG>(p, mt, i >> 1, acc, wr, wc, fr, fq); else epi_regs<EPI_ATT>(p, mt, i >> 1, acc, wr, wc, fr, fq);
            }, smem);
        }
        __syncthreads();
        const char* r1 = ws + OFF_R1 + (size_t)mt * 256 * 1024 * 2;
        {
          const char* wo = ws + OFF_WOUT;
          gemm_stream<1024>(4,
            [&](int i, const char*& A, const char*& B) { A = r1; B = wo + (size_t)i * 256 * 1024 * 2; },
            [&](int i, const f32x4 (&acc)[2][2][4][2], int wr, int wc, int fr, int fq) { epi_regs<EPI_OUT>(p, mt, i, acc, wr, wc, fr, fq); }, smem);
        }
        __syncthreads();
        ln_rows(p, mt, p.ln1g, p.ln1b, (u16*)(ws + OFF_R1));
        __syncthreads();
        {
          const char* wf = ws + OFF_WFI;
          gemm_stream<1024>(22,
            [&](int i, const char*& A, const char*& B) { A = r1; B = wf + (size_t)i * 256 * 1024 * 2; },
            [&](int i, const f32x4 (&acc)[2][2][4][2], int wr, int wc, int fr, int fq) { epi_regs<EPI_FFI>(p, mt, i, acc, wr, wc, fr, fq); }, smem);
        }
        __syncthreads();
        {
          const char* glb = ws + OFF_GL + (size_t)mt * GL_BLOCK; const char* wf = ws + OFF_WFO;
          gemm_stream<DFF>(4,
            [&](int i, const char*& A, const char*& B) { A = glb; B = wf + (size_t)i * 256 * DFF * 2; },
            [&](int i, const f32x4 (&acc)[2][2][4][2], int wr, int wc, int fr, int fq) { epi_regs<EPI_FFO>(p, mt, i, acc, wr, wc, fr, fq); }, smem);
        }
        __syncthreads();
        ln_rows(p, mt, p.ln2g, p.ln2b, nullptr);
      }
    }
  }
}

extern "C" void kernel_launch(void* const* d_in, const int* in_sizes, int n_in, void* d_out, int out_size, void* d_ws, size_t ws_size,
                              hipStream_t stream) {
  static int grid_blocks = 0;
  if (!grid_blocks) {
    if (ws_size < WS_END) { fprintf(stderr, "kernel_launch: workspace too small: %zu < %zu\n", ws_size, (size_t)WS_END); grid_blocks = -1; return; }
    int dev = 0, cus = 0, per_cu = 0;
    hipGetDevice(&dev);
    hipDeviceGetAttribute(&cus, hipDeviceAttributeMultiprocessorCount, dev);
    if (hipFuncSetAttribute((const void*)fwd_megakernel, hipFuncAttributeMaxDynamicSharedMemorySize, LDS_BYTES) != hipSuccess)
      fprintf(stderr, "kernel_launch: hipFuncSetAttribute failed\n");
    hipOccupancyMaxActiveBlocksPerMultiprocessor(&per_cu, (const void*)fwd_megakernel, NT, LDS_BYTES);
    if (per_cu < 1) { fprintf(stderr, "kernel_launch: occupancy query says %d blocks/CU\n", per_cu); per_cu = 1; }
    int g = cus * per_cu;
    if (g > NTILE) g = NTILE;
    grid_blocks = g;
  }
  if (grid_blocks < 0) return;
  Params p{};
  p.x = (const float*)d_in[0]; p.meta = (const float*)d_in[1]; p.lng = (const float*)d_in[2]; p.lnb = (const float*)d_in[3];
  p.w_in = (const float*)d_in[4]; p.hglb = (const float*)d_in[5]; p.hgng = (const float*)d_in[6]; p.sinks = (const float*)d_in[7];
  p.w_bhg = (const float*)d_in[8]; p.w_batt = (const float*)d_in[9]; p.w_out = (const float*)d_in[10];
  p.ln1g = (const float*)d_in[11]; p.ln1b = (const float*)d_in[12]; p.w_fi = (const float*)d_in[13]; p.w_fo = (const float*)d_in[14];
  p.ln2g = (const float*)d_in[15]; p.ln2b = (const float*)d_in[16];
  p.out = (float*)d_out; p.ws = (char*)d_ws;
  constexpr int NPHASE = 5;
  int cuts[MK_LAUNCHES + 1];
  for (int li = 0; li <= MK_LAUNCHES; ++li) cuts[li] = (MK_LAUNCHES == 1) ? (li ? NPHASE : 0) : li;
  for (int li = 0; li < MK_LAUNCHES; ++li) {
    p.ph_lo = cuts[li]; p.ph_hi = cuts[li + 1];
    void* args[] = {&p};
    hipError_t e = hipLaunchCooperativeKernel((const void*)fwd_megakernel, dim3(grid_blocks), dim3(NT), args, LDS_BYTES, stream);
    if (e != hipSuccess) { fprintf(stderr, "cooperative launch %d failed: %s (grid %d)\n", li, hipGetErrorString(e), grid_blocks); break; }
  }
}
```
